# Optimizing an MI355X kernel written in HIP

```python
import math
import jax, jax.numpy as jnp
from jax import lax
import numpy as np

D_MODEL = 1024
BATCH = 4
SEQ = 4096
DEPTH = 2

CHUNK = 64
N_MIXERS = 2
N_S5 = (DEPTH + 1) // 2
N_GLA = DEPTH // 2
S5_GROUP = 16
S5_GROUPS = D_MODEL // S5_GROUP
S5_STATE = 64
DT_MIN = 1e-3
DT_MAX = 1e-1
GLA_HEADS = 4
GLA_QK = D_MODEL // 2
GLA_DK = GLA_QK // GLA_HEADS
GLA_DV = D_MODEL // GLA_HEADS
GLA_GATE_RANK = 16
GLA_GATE_TAU = 16.0
GLA_IN = 2 * GLA_QK + D_MODEL + GLA_GATE_RANK + D_MODEL
D_FF = 4 * D_MODEL
EPS = 1e-6

kernel_name = "chunk_causal_s5_gla_hybrid"


def rmsnorm(x, g):
    xf = x.astype(jnp.float32)
    y = xf * lax.rsqrt(jnp.mean(xf * xf, axis=-1, keepdims=True) + EPS) * g.astype(jnp.float32)
    return y.astype(x.dtype)


def modulate(h, shift, scale):
    return h * (1.0 + scale[:, None, :]) + shift[:, None, :]


def s5_mixer(u, a_re, a_im, log_dt, b_re, b_im, c_re, c_im, d_skip, w_glu):
    bsz, seq, _ = u.shape
    f32 = jnp.float32
    uf = u.astype(f32).reshape(bsz, seq, S5_GROUPS, S5_GROUP)
    dt = jnp.exp(log_dt.astype(f32))[:, None]
    ar = a_re.astype(f32)
    ai = a_im.astype(f32)
    mag = jnp.exp(ar * dt)
    ph = ai * dt
    lb_re = mag * jnp.cos(ph)
    lb_im = mag * jnp.sin(ph)
    den = ar * ar + ai * ai
    nr = lb_re - 1.0
    ni = lb_im
    f_re = (nr * ar + ni * ai) / den
    f_im = (ni * ar - nr * ai) / den
    br = b_re.astype(f32)
    bi = b_im.astype(f32)
    bb_re = f_re[..., None] * br - f_im[..., None] * bi
    bb_im = f_re[..., None] * bi + f_im[..., None] * br
    bu_re = jnp.einsum('blgh,gph->blgp', uf, bb_re)
    bu_im = jnp.einsum('blgh,gph->blgp', uf, bb_im)
    la_re = jnp.broadcast_to(lb_re, bu_re.shape)
    la_im = jnp.broadcast_to(lb_im, bu_im.shape)

    def combine(left, right):
        a1r, a1i, b1r, b1i = left
        a2r, a2i, b2r, b2i = right
        return (a2r * a1r - a2i * a1i,
                a2r * a1i + a2i * a1r,
                a2r * b1r - a2i * b1i + b2r,
                a2r * b1i + a2i * b1r + b2i)

    _, _, xr, xi = lax.associative_scan(combine, (la_re, la_im, bu_re, bu_im), axis=1)
    y = (jnp.einsum('blgp,ghp->blgh', xr, c_re.astype(f32))
         - jnp.einsum('blgp,ghp->blgh', xi, c_im.astype(f32))
         + d_skip.astype(f32).reshape(S5_GROUPS, S5_GROUP) * uf)
    z = jax.nn.gelu(y.reshape(bsz, seq, D_MODEL)).astype(u.dtype)
    val, gate = jnp.split(z @ w_glu, 2, axis=-1)
    return val * jax.nn.sigmoid(gate)


def gla_mixer(h, w_in, w_gate2, b_gate, g_norm, w_out):
    bsz, seq, _ = h.shape
    n = seq // CHUNK
    f32 = jnp.float32
    proj = h @ w_in
    q, k, v, glr, r = jnp.split(
        proj, [GLA_QK, 2 * GLA_QK, 2 * GLA_QK + D_MODEL, 2 * GLA_QK + D_MODEL + GLA_GATE_RANK], axis=-1)
    log_a = jax.nn.log_sigmoid((glr @ w_gate2 + b_gate).astype(f32)) / GLA_GATE_TAU

    def heads(t, dh):
        return t.reshape(bsz, n, CHUNK, GLA_HEADS, dh).transpose(0, 3, 1, 2, 4).astype(f32)

    q = heads(q, GLA_DK) * (GLA_DK ** -0.5)
    k = heads(k, GLA_DK)
    v = heads(v, GLA_DV)
    gc = jnp.cumsum(heads(log_a, GLA_DK), axis=3)
    g_end = gc[:, :, :, -1:, :]
    k_dec = k * jnp.exp(g_end - gc)
    scores = jnp.einsum('bhncd,bhnsd->bhncs', q, k_dec)
    o_intra = jnp.einsum('bhncs,bhnse->bhnce', scores, v)
    kv = jnp.einsum('bhnsd,bhnse->bhnde', k_dec, v)
    decay = jnp.exp(g_end[:, :, :, 0, :])

    def step(state, inp):
        kv_c, dec_c = inp
        return dec_c[..., None] * state + kv_c, state

    s0 = jnp.zeros((bsz, GLA_HEADS, GLA_DK, GLA_DV), f32)
    _, s_prev = lax.scan(step, s0, (kv.transpose(2, 0, 1, 3, 4), decay.transpose(2, 0, 1, 3)))
    s_prev = s_prev.transpose(1, 2, 0, 3, 4)
    o_inter = jnp.einsum('bhncd,bhnde->bhnce', q * jnp.exp(g_end), s_prev)
    o = o_intra + o_inter
    o = o * lax.rsqrt(jnp.mean(o * o, axis=-1, keepdims=True) + EPS)
    o = o.transpose(0, 2, 3, 1, 4).reshape(bsz, seq, D_MODEL) * g_norm.astype(f32)
    o = o.astype(h.dtype) * jax.nn.silu(r)
    return o @ w_out


def sqrelu_mlp(h, w1, w2):
    a = jax.nn.relu(h @ w1)
    return (a * a) @ w2


def setup_inputs(seed: int = 0) -> dict:
    key = jax.random.key(seed)
    ks = jax.random.split(key, 24)
    f32 = jnp.float32
    nrm = lambda k, shape, s: jax.random.normal(k, shape, f32) * s
    x = jax.random.normal(ks[0], (BATCH, SEQ, D_MODEL), f32)
    c = jax.random.normal(ks[1], (BATCH, D_MODEL), f32)
    w_ada = nrm(ks[2], (DEPTH, D_MODEL, 6 * D_MODEL), 0.5 * D_MODEL ** -0.5)
    b_ada = nrm(ks[3], (DEPTH, 6 * D_MODEL), 0.02)
    norm_mix = 1.0 + nrm(ks[4], (DEPTH, D_MODEL), 0.02)
    norm_mlp = 1.0 + nrm(ks[5], (DEPTH, D_MODEL), 0.02)
    n_idx = jnp.arange(S5_STATE, dtype=f32)
    s5_a_re = -0.5 * jnp.exp(nrm(ks[6], (N_S5, S5_GROUPS, S5_STATE), 0.05))
    s5_a_im = math.pi * n_idx + nrm(ks[7], (N_S5, S5_GROUPS, S5_STATE), 0.05)
    s5_log_dt = jax.random.uniform(ks[8], (N_S5, S5_GROUPS), f32, math.log(DT_MIN), math.log(DT_MAX))
    s5_b_re = nrm(ks[9], (N_S5, S5_GROUPS, S5_STATE, S5_GROUP), (2.0 * S5_GROUP) ** -0.5)
    s5_b_im = nrm(ks[10], (N_S5, S5_GROUPS, S5_STATE, S5_GROUP), (2.0 * S5_GROUP) ** -0.5)
    s5_c_re = nrm(ks[11], (N_S5, S5_GROUPS, S5_GROUP, S5_STATE), S5_STATE ** -0.5)
    s5_c_im = nrm(ks[12], (N_S5, S5_GROUPS, S5_GROUP, S5_STATE), S5_STATE ** -0.5)
    s5_d = nrm(ks[13], (N_S5, D_MODEL), 1.0)
    s5_w_glu = nrm(ks[14], (N_S5, D_MODEL, 2 * D_MODEL), D_MODEL ** -0.5)
    gla_w_in = nrm(ks[15], (N_GLA, D_MODEL, GLA_IN), D_MODEL ** -0.5)
    gla_w_gate2 = nrm(ks[16], (N_GLA, GLA_GATE_RANK, GLA_QK), GLA_GATE_RANK ** -0.5)
    gla_b_gate = nrm(ks[17], (N_GLA, GLA_QK), 0.1)
    gla_g_norm = 1.0 + nrm(ks[18], (N_GLA, D_MODEL), 0.02)
    gla_w_out = nrm(ks[19], (N_GLA, D_MODEL, D_MODEL), D_MODEL ** -0.5)
    w_ff1 = nrm(ks[20], (DEPTH, D_MODEL, D_FF), D_MODEL ** -0.5)
    w_ff2 = nrm(ks[21], (DEPTH, D_FF, D_MODEL), D_FF ** -0.5)
    norm_final = 1.0 + nrm(ks[22], (D_MODEL,), 0.02)
    return {"x": x, "c": c, "w_ada": w_ada, "b_ada": b_ada, "norm_mix": norm_mix, "norm_mlp": norm_mlp,
            "s5_a_re": s5_a_re, "s5_a_im": s5_a_im, "s5_log_dt": s5_log_dt, "s5_b_re": s5_b_re,
            "s5_b_im": s5_b_im, "s5_c_re": s5_c_re, "s5_c_im": s5_c_im, "s5_d": s5_d, "s5_w_glu": s5_w_glu,
            "gla_w_in": gla_w_in, "gla_w_gate2": gla_w_gate2, "gla_b_gate": gla_b_gate,
            "gla_g_norm": gla_g_norm, "gla_w_out": gla_w_out, "w_ff1": w_ff1, "w_ff2": w_ff2,
            "norm_final": norm_final}


def reference(x, c, w_ada, b_ada, norm_mix, norm_mlp, s5_a_re, s5_a_im, s5_log_dt, s5_b_re, s5_b_im,
              s5_c_re, s5_c_im, s5_d, s5_w_glu, gla_w_in, gla_w_gate2, gla_b_gate, gla_g_norm, gla_w_out,
              w_ff1, w_ff2, norm_final):
    cs = jax.nn.silu(c)
    for i in range(DEPTH):
        mod = cs @ w_ada[i] + b_ada[i]
        sh1, sc1, gt1, sh2, sc2, gt2 = jnp.split(mod, 6, axis=-1)
        h = modulate(rmsnorm(x, norm_mix[i]), sh1, sc1)
        j = i // N_MIXERS
        if i % N_MIXERS == 0:
            y = s5_mixer(h, s5_a_re[j], s5_a_im[j], s5_log_dt[j], s5_b_re[j], s5_b_im[j],
                         s5_c_re[j], s5_c_im[j], s5_d[j], s5_w_glu[j])
        else:
            y = gla_mixer(h, gla_w_in[j], gla_w_gate2[j], gla_b_gate[j], gla_g_norm[j], gla_w_out[j])
        x = x + gt1[:, None, :] * y
        h = modulate(rmsnorm(x, norm_mlp[i]), sh2, sc2)
        x = x + gt2[:, None, :] * sqrelu_mlp(h, w_ff1[i], w_ff2[i])
    return rmsnorm(x, norm_final)
```

```cpp
#include <hip/hip_runtime.h>
#include <cstdio>
#include <cstdint>
#include <math.h>

#define LAS __attribute__((address_space(3)))
#define GAS __attribute__((address_space(1)))
typedef unsigned short bf16_t;
typedef short bf16x8 __attribute__((ext_vector_type(8)));
typedef float f32x4 __attribute__((ext_vector_type(4)));
typedef float f32x2 __attribute__((ext_vector_type(2)));
typedef unsigned u32x4 __attribute__((ext_vector_type(4)));
typedef unsigned u32x2 __attribute__((ext_vector_type(2)));

constexpr int NB = 4, SEQ = 4096, D = 1024, T = NB * SEQ;
constexpr int G = 64, P = 64, HG = 16;
constexpr int QC = 16, NCH = SEQ / QC, BC = NB * NCH;
constexpr int UK = QC * HG, UA = UK + 2 * P;
constexpr int NH = 4, DK = 128, DV = 256, QKW = 512, RANK = 16, GIN = 3088, DFF = 4096, CH = 64;
constexpr int NQKVR = 3072;
constexpr float EPS = 1e-6f;

constexpr size_t MiB = 1u << 20;
constexpr size_t WS_CTL = 0, CTL_ZERO_BYTES = 1 * MiB;
constexpr size_t WS_MOD = 1 * MiB;
constexpr size_t WS_GLR = 2 * MiB;
constexpr size_t WS_WGLU = 38 * MiB;
constexpr size_t WS_WIN = 42 * MiB;
constexpr size_t WS_WOUT = 4 * MiB;
__host__ __device__ constexpr size_t WS_W1L(int l) { return (l ? 6 : 22) * MiB; }
__host__ __device__ constexpr size_t WS_W2L(int l) { return (l ? 14 : 30) * MiB; }
constexpr size_t WS_TT = 48 * MiB;
constexpr size_t WS_WST = 60 * MiB;
constexpr size_t WS_UAUG = 64 * MiB;
constexpr size_t WS_SLOC = 112 * MiB;
constexpr size_t WS_ZT = 144 * MiB;
constexpr size_t WS_A2 = 64 * MiB;
constexpr size_t WS_QKVR = 64 * MiB;
constexpr size_t WS_KVF = 160 * MiB;
constexpr size_t WS_DEC = 3 * MiB;
constexpr size_t WS_SSP = 240 * MiB;
constexpr size_t WS_XBA = 208 * MiB;
constexpr size_t WS_XBC = 24 * MiB;
constexpr size_t WS_SS = 244 * MiB;
constexpr size_t WS_BIAS1 = 3 * MiB + 512 * 1024;
constexpr size_t WS_BIASIN = WS_BIAS1 + 2 * 4 * 4096 * 4;
constexpr size_t WS_BIASG = WS_BIASIN + 4 * 3072 * 4;
constexpr size_t WS_WGT = WS_BIASG + 4 * 16 * 4;
constexpr size_t WS_AOUT = 208 * MiB;
constexpr size_t WS_END = 250 * MiB;
constexpr int SSL = 32;
constexpr size_t WS_DUMMY = 64 * MiB;
constexpr int CW_BAR = 4096;

constexpr int LDS_BYTES = 147456, LDSCTL_OFF = LDS_BYTES - 512, MISC_OFF = LDSCTL_OFF + 320, RING_BYTES = LDSCTL_OFF;
constexpr int NWAVES = 8, NTHR = NWAVES * 64;

__device__ __forceinline__ unsigned f2bf(float f) { unsigned u = __builtin_bit_cast(unsigned, f); return (u + 0x7fffu + ((u >> 16) & 1u)) >> 16; }
__device__ __forceinline__ unsigned pk2(float lo, float hi) { return f2bf(lo) | (f2bf(hi) << 16); }
__device__ __forceinline__ float bf2f(unsigned short b) { return __builtin_bit_cast(float, (unsigned)b << 16); }
typedef __bf16 bf16x2_t __attribute__((ext_vector_type(2)));
__device__ __forceinline__ unsigned cvt_pk_bf16(float lo, float hi) { const f32x2 v = {lo, hi}; const bf16x2_t b = __builtin_convertvector(v, bf16x2_t); return __builtin_bit_cast(unsigned, b); }
__device__ __forceinline__ float fast_sigmoid(float x) { return __builtin_amdgcn_rcpf(1.f + __builtin_amdgcn_exp2f(-1.4426950408889634f * x)); }
__device__ __forceinline__ float fast_gelu_tanh(float x) { const float u = 0.7978845608028654f * (x + 0.044715f * x * x * x); return x * fast_sigmoid(2.f * u); }
__device__ __forceinline__ float silu_f(float x) { return x / (1.f + expf(-x)); }
__device__ __forceinline__ float logsigmoid_f(float x) { return fminf(x, 0.f) - log1pf(expf(-fabsf(x))); }
__device__ __forceinline__ float wave_sum(float v) {
#pragma unroll
    for (int o = 1; o < 64; o <<= 1) v += __shfl_xor(v, o);
    return v;
}
__device__ __forceinline__ float sum_groups16(float x) {
    const unsigned u = __builtin_bit_cast(unsigned, x);
    auto r = __builtin_amdgcn_permlane16_swap(u, u, false, false);
    const float y = __builtin_bit_cast(float, (unsigned)r[0]) + __builtin_bit_cast(float, (unsigned)r[1]);
    const unsigned v = __builtin_bit_cast(unsigned, y);
    auto q = __builtin_amdgcn_permlane32_swap(v, v, false, false);
    return __builtin_bit_cast(float, (unsigned)q[0]) + __builtin_bit_cast(float, (unsigned)q[1]);
}
#define LDS_WAIT() asm volatile("s_waitcnt lgkmcnt(0)" ::: "memory")
#define WG_BAR() do { asm volatile("s_waitcnt lgkmcnt(0)" ::: "memory"); __builtin_amdgcn_s_barrier(); asm volatile("" ::: "memory"); } while (0)
#define VM_WAIT() asm volatile("s_waitcnt vmcnt(0)" ::: "memory")

namespace pg8 {
constexpr int BM = 256, BK = 64, HALF = 128, HTB = HALF * BK * 2, STAGE_BYTES = 8 * HTB, NXCD = 8, WGM = 8;
__host__ __device__ __forceinline__ int lds_byte(int r, int c) { const int st = (r >> 4) * 2 + (c >> 5), rr = r & 15, cc = c & 31, ob = rr * 64 + cc * 2; return st * 1024 + (ob ^ (((ob >> 9) & 1) << 5)); }
__host__ __device__ __forceinline__ void stage_rc(int b, int& R, int& C) { const int st = b / 1024, sb = b % 1024, swz = sb ^ (((sb >> 9) & 1) << 5); R = (st >> 1) * 16 + swz / 64; C = (st & 1) * 32 + (swz % 64) / 2; }
__host__ __device__ __forceinline__ int perm32(int rho) { const int n = rho >> 4, i = rho & 15; return 8 * (i >> 2) + 4 * n + (i & 3); }
struct Unit { int pm, pn; };
struct StaticOrder {
    int nM, nN, nwg, G, c;
    __device__ void init(int M, int N, int G_, int c_) { nM = M / BM; nN = N / BM; nwg = nM * nN; G = G_; c = c_; }
    __device__ bool next(int i, Unit& u) const {
        const long L = (long)i * G + c; if (L >= nwg) return false;
        int wgid = (int)L; { const int q = nwg / NXCD, r = nwg % NXCD, xcd = wgid % NXCD, off = wgid / NXCD; wgid = (xcd < r ? xcd * (q + 1) : r * (q + 1) + (xcd - r) * q) + off; }
        const int nig = WGM * nN, gid = wgid / nig, fm = gid * WGM, gsz = (nM - fm) < WGM ? (nM - fm) : WGM;
        u.pm = fm + ((wgid % nig) % gsz); u.pn = (wgid % nig) / gsz; return true;
    }
};
template <class Prob, bool ALIGN_EPI, bool SP2>
__device__ __forceinline__ void gemm_phase(LAS unsigned char* lds, const Prob& Pb) {
    const int tid = threadIdx.x, wid = __builtin_amdgcn_readfirstlane(tid >> 6), lane = tid & 63, wr = wid >> 2, wc = wid & 3, fr = lane & 15, fq = lane >> 4;
    const int K = Pb.K, nt = K / BK;
    unsigned voffA[2], voffB[2];
#pragma unroll
    for (int i = 0; i < 2; ++i) { int R, C; stage_rc(tid * 16 + i * 8192, R, C); const int Rb = Prob::PERM ? ((R & ~31) + perm32(R & 31)) : R;
        voffA[i] = Pb.a_voff(R, C); voffB[i] = (unsigned)(Rb * Pb.ldb + C) * 2u; }
    const size_t kstepA = Pb.a_kstep, hstepA = Pb.a_hstep, kstepB = (size_t)(BK * 2), hstepB = (size_t)HALF * Pb.ldb * 2;
    const unsigned ldsw = (unsigned)wid * 1024u;
    const int aoff = lds_byte(wr * 64 + fr, fq * 8), boff = lds_byte(wc * 32 + fr, fq * 8);
#define PG8_SA(b, h) (((b) * 2 + (h)) * HTB)
#define PG8_SB(b, h) ((4 + (b) * 2 + (h)) * HTB)
#define PG8_STAGE(bufoff, gbase, voff) do { _Pragma("unroll") for (int _i = 0; _i < 2; ++_i) \
        __builtin_amdgcn_global_load_lds((const unsigned*)((const char*)(gbase) + (voff)[_i]), (LAS unsigned*)(lds + (bufoff) + ldsw + _i * 8192), 16, 0, 0); } while (0)
#define PG8_LDA(dst, b, h) do { _Pragma("unroll") for (int m = 0; m < 4; ++m) _Pragma("unroll") for (int k = 0; k < 2; ++k) dst[m][k] = *(const LAS bf16x8*)(lds + PG8_SA(b, h) + aoff + m * 2048 + k * 1024); } while (0)
#define PG8_LDB(dst, b, h) do { _Pragma("unroll") for (int n = 0; n < 2; ++n) _Pragma("unroll") for (int k = 0; k < 2; ++k) dst[n][k] = *(const LAS bf16x8*)(lds + PG8_SB(b, h) + boff + n * 2048 + k * 1024); } while (0)
#define PG8_MMA(ai, bj, At, Bt) do { __builtin_amdgcn_s_setprio(1); _Pragma("unroll") for (int m = 0; m < 4; ++m) _Pragma("unroll") for (int n = 0; n < 2; ++n) _Pragma("unroll") for (int k = 0; k < 2; ++k) \
        acc[ai][bj][m][n] = __builtin_amdgcn_mfma_f32_16x16x32_bf16(Bt[n][k], At[m][k], acc[ai][bj][m][n], 0, 0, 0); __builtin_amdgcn_s_setprio(0); } while (0)
#define PG8_WAIT_V(n) asm volatile("s_waitcnt vmcnt(" #n ")" ::: "memory")
#define PG8_WAIT_L(n) asm volatile("s_waitcnt lgkmcnt(" #n ")" ::: "memory")
#define PG8_BAR __builtin_amdgcn_s_barrier()
#define PG8_SCHED __builtin_amdgcn_sched_barrier(0)
    Unit cur, nxt; int ui = 0;
    if (!Pb.next(0, cur)) return;
    Pb.prep(lds);
    f32x4 acc[2][2][4][2];
#pragma unroll
    for (int a = 0; a < 2; ++a)
#pragma unroll
        for (int b = 0; b < 2; ++b)
#pragma unroll
            for (int m = 0; m < 4; ++m)
#pragma unroll
                for (int n = 0; n < 2; ++n) acc[a][b][m][n] = (f32x4){0.f, 0.f, 0.f, 0.f};
    bf16x8 At[4][2], B0[2][2], B1[2][2];
    const char* cA = Pb.a_base(cur); const char* cB = Pb.b_base(cur);
    if constexpr (SP2) {
        PG8_STAGE(PG8_SB(0, 0), cB, voffB); PG8_STAGE(PG8_SB(0, 1), cB + hstepB, voffB); PG8_STAGE(PG8_SA(0, 0), cA, voffA); PG8_STAGE(PG8_SA(0, 1), cA + hstepA, voffA);
        if (wr == 1) PG8_BAR;
        PG8_WAIT_V(2); PG8_BAR;
        PG8_STAGE(PG8_SB(1, 0), cB + kstepB, voffB); PG8_STAGE(PG8_SA(1, 0), cA + kstepA, voffA); PG8_STAGE(PG8_SB(1, 1), cB + hstepB + kstepB, voffB);
        PG8_WAIT_V(6); PG8_BAR;
    } else {
        PG8_STAGE(PG8_SB(0, 0), cB, voffB); PG8_STAGE(PG8_SA(0, 0), cA, voffA); PG8_STAGE(PG8_SB(0, 1), cB + hstepB, voffB); PG8_STAGE(PG8_SA(0, 1), cA + hstepA, voffA);
        if (wr == 1) PG8_BAR;
        PG8_WAIT_V(4); PG8_BAR;
        PG8_STAGE(PG8_SB(1, 0), cB + kstepB, voffB); PG8_STAGE(PG8_SA(1, 0), cA + kstepA, voffA); PG8_STAGE(PG8_SB(1, 1), cB + hstepB + kstepB, voffB);
        PG8_WAIT_V(6); PG8_BAR;
    }
    for (;;) {
        const bool has_next = Pb.next(ui + 1, nxt);
        const char* nA = has_next ? Pb.a_base(nxt) : cA; const char* nB = has_next ? Pb.b_base(nxt) : cB;
        for (int t = 0; t < nt; t += 2) {
            const bool last = (t == nt - 2);
            const char* a1 = cA + (size_t)(t + 1) * kstepA;
            const char* a2 = last ? nA : cA + (size_t)(t + 2) * kstepA; const char* b2 = last ? nB : cB + (size_t)(t + 2) * kstepB;
            const char* a3 = a2 + kstepA; const char* b3 = b2 + kstepB;
            if constexpr (SP2) {
            PG8_LDB(B0, 0, 0); PG8_LDB(B1, 0, 1); PG8_SCHED; PG8_LDA(At, 0, 0); PG8_STAGE(PG8_SA(1, 1), a1 + hstepA, voffA);
            PG8_WAIT_V(8); PG8_WAIT_L(0); PG8_BAR; PG8_MMA(0, 0, At, B0); PG8_MMA(0, 1, At, B1); PG8_BAR; PG8_SCHED;
            PG8_LDA(At, 0, 1); PG8_STAGE(PG8_SB(0, 0), b2, voffB); PG8_STAGE(PG8_SB(0, 1), b2 + hstepB, voffB); PG8_STAGE(PG8_SA(0, 0), a2, voffA);
            PG8_WAIT_V(8); PG8_WAIT_L(0); PG8_BAR; PG8_MMA(1, 0, At, B0); PG8_MMA(1, 1, At, B1); PG8_BAR; PG8_SCHED;
            PG8_LDB(B0, 1, 0); PG8_LDB(B1, 1, 1); PG8_SCHED; PG8_LDA(At, 1, 0); PG8_STAGE(PG8_SA(0, 1), a2 + hstepA, voffA);
            PG8_WAIT_V(8); PG8_WAIT_L(0); PG8_BAR; PG8_MMA(0, 0, At, B0); PG8_MMA(0, 1, At, B1); PG8_BAR; PG8_SCHED;
            PG8_LDA(At, 1, 1); PG8_STAGE(PG8_SB(1, 0), b3, voffB); PG8_STAGE(PG8_SB(1, 1), b3 + hstepB, voffB); PG8_STAGE(PG8_SA(1, 0), a3, voffA);
            PG8_WAIT_V(8); PG8_WAIT_L(0); PG8_BAR; PG8_MMA(1, 0, At, B0); PG8_MMA(1, 1, At, B1); PG8_BAR; PG8_SCHED;
            } else {
            PG8_LDB(B0, 0, 0); PG8_SCHED; PG8_LDA(At, 0, 0); PG8_STAGE(PG8_SA(1, 1), a1 + hstepA, voffA);
            PG8_WAIT_L(8); PG8_BAR; PG8_WAIT_L(0); PG8_MMA(0, 0, At, B0); PG8_BAR; PG8_SCHED;
            PG8_LDB(B1, 0, 1); PG8_STAGE(PG8_SB(0, 0), b2, voffB);
            PG8_BAR; PG8_WAIT_L(0); PG8_MMA(0, 1, At, B1); PG8_BAR;
            PG8_LDA(At, 0, 1); PG8_STAGE(PG8_SA(0, 0), a2, voffA);
            PG8_BAR; PG8_WAIT_L(0); PG8_MMA(1, 0, At, B0); PG8_BAR; PG8_SCHED;
            PG8_STAGE(PG8_SB(0, 1), b2 + hstepB, voffB);
            PG8_WAIT_V(6); PG8_BAR; PG8_MMA(1, 1, At, B1); PG8_BAR;
            PG8_LDB(B0, 1, 0); PG8_SCHED; PG8_LDA(At, 1, 0); PG8_STAGE(PG8_SA(0, 1), a2 + hstepA, voffA);
            PG8_WAIT_L(8); PG8_BAR; PG8_WAIT_L(0); PG8_MMA(0, 0, At, B0); PG8_BAR; PG8_SCHED;
            PG8_LDB(B1, 1, 1); PG8_STAGE(PG8_SB(1, 0), b3, voffB);
            PG8_BAR; PG8_WAIT_L(0); PG8_MMA(0, 1, At, B1); PG8_BAR;
            PG8_LDA(At, 1, 1); PG8_STAGE(PG8_SA(1, 0), a3, voffA);
            PG8_BAR; PG8_WAIT_L(0); PG8_MMA(1, 0, At, B0); PG8_BAR; PG8_SCHED;
            PG8_STAGE(PG8_SB(1, 1), b3 + hstepB, voffB);
            PG8_WAIT_V(6); PG8_BAR; PG8_MMA(1, 1, At, B1); PG8_BAR;
            }
        }
        if constexpr (ALIGN_EPI) { if (wr == 0) PG8_BAR; }
        Pb.epi(acc, cur, ui, lds, wr, wc, fr, fq);
        if (!has_next) break;
#pragma unroll
        for (int a = 0; a < 2; ++a)
#pragma unroll
            for (int b = 0; b < 2; ++b)
#pragma unroll
                for (int m = 0; m < 4; ++m)
#pragma unroll
                    for (int n = 0; n < 2; ++n) acc[a][b][m][n] = (f32x4){0.f, 0.f, 0.f, 0.f};
        cur = nxt; cA = nA; cB = nB; ++ui;
        if constexpr (ALIGN_EPI) { if (wr == 1) PG8_BAR; }
    }
    PG8_WAIT_V(0);
    if constexpr (!ALIGN_EPI) { if (wr == 0) PG8_BAR; }
    PG8_BAR;
#undef PG8_SA
#undef PG8_SB
#undef PG8_STAGE
#undef PG8_LDA
#undef PG8_LDB
#undef PG8_MMA
#undef PG8_WAIT_V
#undef PG8_WAIT_L
#undef PG8_BAR
#undef PG8_SCHED
}
}
using pg8::Unit;
typedef f32x4 AccT[2][2][4][2];

#define XB_TMO      128
#define XB_XCNT(j)  (256  + 64 * (j))
#define XB_XSUB(j)  (1280 + 64 * (j))
#define XB_XGEN(j)  (2304 + 64 * (j))
#define XB_TOP      3328
#define XB_TOPGEN   3392
#define XCD_BAR_WORDS 3456
#define XB_SPIN_CAP (1u << 18)
__device__ __forceinline__ unsigned xb_ld(unsigned* p)              { return __hip_atomic_load(p, __ATOMIC_RELAXED, __HIP_MEMORY_SCOPE_AGENT); }
__device__ __forceinline__ unsigned xb_add(unsigned* p, unsigned v) { return __hip_atomic_fetch_add(p, v, __ATOMIC_RELAXED, __HIP_MEMORY_SCOPE_AGENT); }
__device__ __forceinline__ unsigned xb_xcc_id() { return (unsigned)__builtin_amdgcn_s_getreg((3 << 11) | 20) & 0xFu; }
#define XB_SPIN(cond, bar) do { unsigned _sp = 0; while (cond) { __builtin_amdgcn_s_sleep(1); \
    if ((++_sp & 255u) == 0u) { if (xb_ld(&(bar)[XB_TMO])) break; if (_sp > XB_SPIN_CAP) { atomicAdd(&(bar)[XB_TMO], 1u); break; } } } } while (0)
struct XcdBarrier { unsigned* bar; unsigned x; volatile LAS unsigned* st; };
__device__ __forceinline__ XcdBarrier xcd_barrier_post(unsigned* bar, volatile LAS unsigned* st) {
    XcdBarrier b; b.bar = bar; b.x = xb_xcc_id(); b.st = st;
    if (threadIdx.x == 0) (void)xb_add(&bar[XB_XCNT(b.x)], 1u);
    return b;
}
__device__ __forceinline__ void xcd_barrier_complete(unsigned* bar, unsigned x, unsigned& nloc, unsigned& nx) {
    const unsigned Gn = gridDim.x * gridDim.y * gridDim.z;
    unsigned sum, cnt, mine, sp = 0u;
    for (;;) {
        sum = 0u; cnt = 0u; mine = 0u;
#pragma unroll
        for (unsigned j = 0; j < 16; ++j) { const unsigned c = xb_ld(&bar[XB_XCNT(j)]); sum += c; cnt += (c > 0u) ? 1u : 0u; mine = (j == x) ? c : mine; }
        if (sum == Gn) break;
        __builtin_amdgcn_s_sleep(1);
        if ((++sp & 255u) == 0u) { if (xb_ld(&bar[XB_TMO])) break; if (sp > XB_SPIN_CAP) { atomicAdd(&bar[XB_TMO], 1u); break; } }
    }
    nloc = mine > 0u ? mine : 1u; nx = cnt > 0u ? cnt : 1u;
}
__device__ __forceinline__ void xcd_barrier(const XcdBarrier& b) {
    asm volatile("s_waitcnt vmcnt(0)" ::: "memory");
    __syncthreads();
    if (threadIdx.x == 0) {
        unsigned* bar = b.bar;
        __builtin_amdgcn_s_waitcnt(0);
        unsigned nloc = b.st[0], nx = b.st[1];
        if (nloc == 0u) { xcd_barrier_complete(bar, b.x, nloc, nx); b.st[0] = nloc; b.st[1] = nx; }
        const unsigned old = xb_add(&bar[XB_XSUB(b.x)], 1u);
        const unsigned gen = old / nloc;
        if (old + 1u == (gen + 1u) * nloc) {
            __builtin_amdgcn_fence(__ATOMIC_RELEASE, "agent");
            asm volatile("s_waitcnt vmcnt(0)" ::: "memory");
            const unsigned og = xb_add(&bar[XB_TOP], 1u);
            const unsigned tg = og / nx;
            if (og + 1u == (tg + 1u) * nx) xb_add(&bar[XB_TOPGEN], 1u);
            else XB_SPIN(xb_ld(&bar[XB_TOPGEN]) == tg, bar);
            __builtin_amdgcn_fence(__ATOMIC_ACQUIRE, "agent");
            xb_add(&bar[XB_XGEN(b.x)], 1u);
            asm volatile("s_waitcnt vmcnt(0)" ::: "memory");
        } else {
            XB_SPIN(xb_ld(&bar[XB_XGEN(b.x)]) == gen, bar);
            __builtin_amdgcn_fence(__ATOMIC_ACQUIRE, "agent");
            asm volatile("s_waitcnt vmcnt(0)" ::: "memory");
        }
    }
    __syncthreads();
}

struct Args { const float* in[23]; float* out; unsigned char* ws; unsigned long long pmask; };
struct Frame {
    LAS unsigned char* lds; int tid, lane, wave, G, bid;
    const float* in[23]; float* out; unsigned char* ws;
};

__device__ __forceinline__ void phase_mod(Frame& F) {
    const float* c = F.in[1]; const float* w_ada = F.in[2]; const float* b_ada = F.in[3]; float* mod = (float*)(F.ws + WS_MOD);
    LAS float* cs = (LAS float*)F.lds;
    LAS f32x4* part = (LAS f32x4*)(F.lds + 16384);
    for (int i = F.tid; i < NB * D; i += NTHR) cs[i] = silu_f(c[i]);
    __syncthreads();
    for (int blk = F.bid; blk < 2 * 6 * D / 48; blk += F.G) {
        const int gn0 = blk * 48, li = gn0 / (6 * D), n0 = gn0 % (6 * D);
        const int kq = F.lane / 12, cq = F.lane % 12; const bool act = F.lane < 60;
        const float* w = w_ada + (size_t)li * D * 6 * D + n0 + 4 * cq;
        f32x4 a0 = (f32x4){0.f, 0.f, 0.f, 0.f}, a1 = a0, a2 = a0, a3 = a0;
        if (act) {
#pragma unroll 13
            for (int i = 0; i < 26; ++i) { const int kl = kq + 5 * i; if (kl < 128) { const int k = 128 * F.wave + kl; const f32x4 wv = *(const GAS f32x4*)(w + (size_t)k * 6 * D);
                a0 += cs[k] * wv; a1 += cs[D + k] * wv; a2 += cs[2 * D + k] * wv; a3 += cs[3 * D + k] * wv; } }
            LAS f32x4* pp = part + ((F.wave * 5 + kq) * 12 + cq) * 4; pp[0] = a0; pp[1] = a1; pp[2] = a2; pp[3] = a3;
        }
        __syncthreads();
        if (F.tid < 48 * NB) { const int bq = F.tid / 48, col = F.tid % 48, cq2 = col >> 2, e = col & 3; float sum = 0.f;
            for (int i = 0; i < 40; ++i) sum += part[(i * 12 + cq2) * 4 + bq][e];
            mod[((size_t)li * NB + bq) * 6 * D + n0 + col] = sum + b_ada[li * 6 * D + n0 + col]; }
        __syncthreads();
    }
}
__device__ __forceinline__ void transpose_item(const float* W, int ldw, int src_col0, bf16_t* WT, int Kd, int dst_row0, int k0, float scale, LAS float* scr, int lane) {
    const int kr = lane >> 4, c4 = lane & 15;
#pragma unroll 8
    for (int i = 0; i < 16; ++i) { const int kk = 4 * i + kr; const f32x4 v = *(const GAS f32x4*)(W + (size_t)(k0 + kk) * ldw + src_col0 + 4 * c4) * scale;
        LAS float* d = scr + kk * 65 + 4 * c4; d[0] = v.x; d[1] = v.y; d[2] = v.z; d[3] = v.w; }
    LDS_WAIT(); asm volatile("" ::: "memory");
    const int c = lane & 7;
#pragma unroll
    for (int j = 0; j < 8; ++j) { const int n = (lane >> 3) + 8 * j; const LAS float* sp = scr + (8 * c) * 65 + n;
        u32x4 o; o.x = pk2(sp[0 * 65], sp[1 * 65]); o.y = pk2(sp[2 * 65], sp[3 * 65]); o.z = pk2(sp[4 * 65], sp[5 * 65]); o.w = pk2(sp[6 * 65], sp[7 * 65]);
        *(GAS u32x4*)(WT + (size_t)(dst_row0 + n) * Kd + k0 + 8 * c) = o; }
    LDS_WAIT(); asm volatile("" ::: "memory");
}
__device__ __forceinline__ void phase_convert(Frame& F) {
    LAS float* scr = (LAS float*)(F.lds + F.wave * 16640);
    const int gw = F.bid * NWAVES + F.wave, NGW = F.G * NWAVES;
    constexpr int I_GLU = (D / 64) * (2 * D / 64), I_IN = (D / 64) * (NQKVR / 64), I_OUT = (D / 64) * (D / 64), I_1 = (D / 64) * (DFF / 64), I_2 = (DFF / 64) * (D / 64);
    constexpr int NITEMS = I_GLU + I_IN + I_OUT + 2 * I_1 + 2 * I_2;
    bf16_t* WGLU = (bf16_t*)(F.ws + WS_WGLU); bf16_t* WIN = (bf16_t*)(F.ws + WS_WIN); bf16_t* WOUT = (bf16_t*)(F.ws + WS_WOUT);
    for (int it = gw; it < NITEMS; it += NGW) {
        int r = it;
        if (r < I_GLU) { const int nblk = 2 * D / 64, kb = r / nblk, nb = r % nblk, n0 = nb * 64;
            const int isg = n0 >= D, nn = isg ? n0 - D : n0, drow = 256 * (nn / 128) + 128 * isg + (nn % 128);
            transpose_item(F.in[14], 2 * D, n0, WGLU, D, drow, kb * 64, 1.f, scr, F.lane); continue; } r -= I_GLU;
        if (r < I_IN) { const int nblk = NQKVR / 64, kb = r / nblk, nb = r % nblk, n0 = nb * 64; const int src = n0 < 2048 ? n0 : n0 + RANK;
            transpose_item(F.in[15], GIN, src, WIN, D, n0, kb * 64, n0 < QKW ? 0.08838834764831845f : 1.f, scr, F.lane); continue; } r -= I_IN;
        if (r < I_OUT) { const int nblk = D / 64, kb = r / nblk, nb = r % nblk; transpose_item(F.in[19], D, nb * 64, WOUT, D, nb * 64, kb * 64, 1.f, scr, F.lane); continue; } r -= I_OUT;
        if (r < 2 * I_1) { const int l = r / I_1; r -= l * I_1; const int nblk = DFF / 64, kb = r / nblk, nb = r % nblk;
            transpose_item(F.in[20] + (size_t)l * D * DFF, DFF, nb * 64, (bf16_t*)(F.ws + WS_W1L(l)), D, nb * 64, kb * 64, 1.f, scr, F.lane); continue; } r -= 2 * I_1;
        { const int l = r / I_2; r -= l * I_2; const int nblk = D / 64, kb = r / nblk, nb = r % nblk;
            transpose_item(F.in[21] + (size_t)l * DFF * D, D, nb * 64, (bf16_t*)(F.ws + WS_W2L(l)), DFF, nb * 64, kb * 64, 1.f, scr, F.lane); }
    }
    __syncthreads();
}
__device__ __forceinline__ void phase_bias(Frame& F) {
    const float* MOD = (const float*)(F.ws + WS_MOD);
    LAS float* vs = (LAS float*)F.lds;
    LAS f32x4* part = (LAS f32x4*)(F.lds + 16384);
    const int j = F.bid;
    if (j < 176) {
        const float* W; int ldw, src; float scale; const float* vec; float* out; int ostride;
        if (j < 128) { const int l = j >> 6, jj = j & 63; W = F.in[20] + (size_t)l * D * DFF; ldw = DFF; src = 64 * jj; scale = 1.f; vec = MOD + (size_t)l * NB * 6 * D + 3 * D;
            out = (float*)(F.ws + WS_BIAS1) + (size_t)l * NB * DFF + 64 * jj; ostride = DFF; }
        else { const int jj = j - 128, n0 = 64 * jj; W = F.in[15]; ldw = GIN; src = n0 < 2048 ? n0 : n0 + RANK; scale = n0 < QKW ? 0.08838834764831845f : 1.f; vec = MOD + (size_t)NB * 6 * D;
            out = (float*)(F.ws + WS_BIASIN) + n0; ostride = NQKVR; }
        for (int i = F.tid; i < NB * D; i += NTHR) vs[i] = vec[(size_t)(i >> 10) * 6 * D + (i & 1023)];
        __syncthreads();
        const int kq = F.lane >> 4, cq = F.lane & 15;
        f32x4 a0 = (f32x4){0.f, 0.f, 0.f, 0.f}, a1 = a0, a2 = a0, a3 = a0;
#pragma unroll 8
        for (int i = 0; i < 32; ++i) { const int k = 128 * F.wave + kq + 4 * i; const f32x4 wv = *(const GAS f32x4*)(W + (size_t)k * ldw + src + 4 * cq);
            a0 += vs[k] * wv; a1 += vs[D + k] * wv; a2 += vs[2 * D + k] * wv; a3 += vs[3 * D + k] * wv; }
        LAS f32x4* pp = part + ((F.wave * 4 + kq) * 16 + cq) * 4; pp[0] = a0; pp[1] = a1; pp[2] = a2; pp[3] = a3;
        __syncthreads();
        if (F.tid < 256) { const int bq = F.tid >> 6, col = F.tid & 63, cq2 = col >> 2, e = col & 3; float sum = 0.f;
            for (int i = 0; i < 32; ++i) sum += part[(i * 16 + cq2) * 4 + bq][e];
            out[(size_t)bq * ostride + col] = sum * scale; }
    } else if (j == 176) {
        const float* w_in = F.in[15]; float* BG = (float*)(F.ws + WS_BIASG); bf16_t* WGT = (bf16_t*)(F.ws + WS_WGT);
        if (F.tid < 64) { const int bq = F.tid >> 4, r = F.tid & 15; const float* sh = MOD + (size_t)NB * 6 * D + (size_t)bq * 6 * D; float sum = 0.f;
            for (int k = 0; k < D; ++k) sum += sh[k] * w_in[(size_t)k * GIN + 2048 + r];
            BG[bq * 16 + r] = sum; }
        for (int i = F.tid; i < RANK * D; i += NTHR) { const int r = i >> 10, k = i & 1023; WGT[i] = (bf16_t)f2bf(w_in[(size_t)k * GIN + 2048 + r]); }
    }
    __syncthreads();
}
__device__ __forceinline__ void phase_s5tables(Frame& F) {
    LAS float* LAMP = (LAS float*)F.lds;
    LAS float* BB = LAMP + 17 * 64 * 2;
    LAS float* CC = BB + 64 * 16 * 2;
    LAS float* KK = CC + 16 * 64 * 2;
    const float* a_re = F.in[6]; const float* a_im = F.in[7]; const float* log_dt = F.in[8]; const float* b_re = F.in[9]; const float* b_im = F.in[10];
    const float* c_re = F.in[11]; const float* c_im = F.in[12]; const float* dsk = F.in[13];
    bf16_t* TT = (bf16_t*)(F.ws + WS_TT); bf16_t* WST = (bf16_t*)(F.ws + WS_WST);
    for (int job = F.bid; job < 4 * G; job += F.G) { const int g = job >> 2, qt = job & 3;
        __syncthreads();
        const double dt = exp((double)log_dt[g]);
        for (int idx = F.tid; idx < 17 * 64; idx += NTHR) { const int m = idx >> 6, p = idx & 63; const double ar = a_re[g * P + p], ai = a_im[g * P + p];
            const double mag = exp(ar * dt * m), ph = ai * dt * m; LAMP[idx * 2] = (float)(mag * cos(ph)); LAMP[idx * 2 + 1] = (float)(mag * sin(ph)); }
        for (int idx = F.tid; idx < 64 * 16; idx += NTHR) { const int p = idx >> 4, hh = idx & 15; const double ar = a_re[g * P + p], ai = a_im[g * P + p];
            const double mag = exp(ar * dt), ph = ai * dt, lr = mag * cos(ph), li = mag * sin(ph), den = ar * ar + ai * ai, nr = lr - 1.0, ni = li;
            const double fr = (nr * ar + ni * ai) / den, fi = (ni * ar - nr * ai) / den; const double br = b_re[(g * P + p) * HG + hh], bi = b_im[(g * P + p) * HG + hh];
            BB[idx * 2] = (float)(fr * br - fi * bi); BB[idx * 2 + 1] = (float)(fr * bi + fi * br); }
        for (int idx = F.tid; idx < 16 * 64; idx += NTHR) { CC[idx * 2] = c_re[g * HG * P + idx]; CC[idx * 2 + 1] = c_im[g * HG * P + idx]; }
        __syncthreads();
        for (int idx = F.tid; idx < 16 * 16 * 16; idx += NTHR) { const int m = idx >> 8, hh = (idx >> 4) & 15, h2 = idx & 15; float s = 0.f;
            for (int p = 0; p < P; ++p) { const float cr = CC[(hh * 64 + p) * 2], ci = CC[(hh * 64 + p) * 2 + 1], lr = LAMP[(m * 64 + p) * 2], li = LAMP[(m * 64 + p) * 2 + 1];
                const float clr = cr * lr - ci * li, cli = cr * li + ci * lr; s += clr * BB[(p * 16 + h2) * 2] - cli * BB[(p * 16 + h2) * 2 + 1]; }
            KK[idx] = s; }
        __syncthreads();
        for (int pc = F.tid; pc < 64 * 48; pc += NTHR) { const int row = 64 * qt + pc / 48, q = pc % 48, j = row >> 4, hh = row & 15; float v[8];
            if (q < 32) { const int s = q >> 1, h0 = (q & 1) * 8;
#pragma unroll
                for (int e = 0; e < 8; ++e) { float x = (j >= s) ? KK[((j - s) * 16 + hh) * 16 + h0 + e] : 0.f; if (s == j && hh == h0 + e) x += dsk[g * HG + hh]; v[e] = x; } }
            else {
#pragma unroll
                for (int e = 0; e < 8; ++e) { const int pcol = (q - 32) * 8 + e, p = pcol & 63; const float cr = CC[(hh * 64 + p) * 2], ci = CC[(hh * 64 + p) * 2 + 1], lr = LAMP[((j + 1) * 64 + p) * 2], li = LAMP[((j + 1) * 64 + p) * 2 + 1];
                    v[e] = pcol < 64 ? (cr * lr - ci * li) : -(cr * li + ci * lr); } }
            u32x4 o; o.x = pk2(v[0], v[1]); o.y = pk2(v[2], v[3]); o.z = pk2(v[4], v[5]); o.w = pk2(v[6], v[7]);
            *(GAS u32x4*)(TT + ((size_t)g * 256 + row) * UA + q * 8) = o; }
        for (int pc = F.tid; pc < 32 * 32; pc += NTHR) { const int row = 32 * qt + (pc >> 5), q = pc & 31, p = row & 63, s = q >> 1, h0 = (q & 1) * 8; float v[8];
            const float lr = LAMP[((15 - s) * 64 + p) * 2], li = LAMP[((15 - s) * 64 + p) * 2 + 1];
#pragma unroll
            for (int e = 0; e < 8; ++e) { const float br = BB[(p * 16 + h0 + e) * 2], bi = BB[(p * 16 + h0 + e) * 2 + 1]; v[e] = row < 64 ? (lr * br - li * bi) : (lr * bi + li * br); }
            u32x4 o; o.x = pk2(v[0], v[1]); o.y = pk2(v[2], v[3]); o.z = pk2(v[4], v[5]); o.w = pk2(v[6], v[7]);
            *(GAS u32x4*)(WST + ((size_t)g * 128 + row) * UK + q * 8) = o; }
    }
    __syncthreads();
}

__device__ __forceinline__ void normmod_row(const float* xrow, const float* nw, const float* sh, const float* sc, int lane, f32x4 (&v)[4]) {
    const GAS f32x4* xr = (const GAS f32x4*)xrow + lane; float s = 0.f;
#pragma unroll
    for (int j = 0; j < 4; ++j) { v[j] = xr[64 * j]; s += (v[j].x * v[j].x + v[j].y * v[j].y) + (v[j].z * v[j].z + v[j].w * v[j].w); }
    const float rstd = 1.0f / sqrtf(wave_sum(s) * (1.f / D) + EPS);
#pragma unroll
    for (int j = 0; j < 4; ++j) { const f32x4 w = ((const GAS f32x4*)nw)[lane + 64 * j]; v[j] = v[j] * rstd * w;
        if (sc) { const f32x4 a = ((const GAS f32x4*)sc)[lane + 64 * j], b = ((const GAS f32x4*)sh)[lane + 64 * j]; v[j] = v[j] * (1.f + a) + b; } }
}
__device__ __forceinline__ void phase_upass(Frame& F) {
    const float* x = F.in[0]; const float* nw = F.in[4]; const float* mod = (const float*)(F.ws + WS_MOD); bf16_t* UAUG = (bf16_t*)(F.ws + WS_UAUG);
    const int gw = F.bid * NWAVES + F.wave, NGW = F.G * NWAVES;
    for (int m = gw; m < T; m += NGW) {
        const int b = m / SEQ, tt = m % SEQ, c = tt / QC, s = tt % QC; const float* mb = mod + (size_t)b * 6 * D;
        f32x4 v[4]; normmod_row(x + (size_t)m * D, nw, mb, mb + D, F.lane, v);
#pragma unroll
        for (int j = 0; j < 4; ++j) { const int g = (F.lane >> 2) + 16 * j, h0 = 4 * (F.lane & 3);
            u32x2 o; o.x = pk2(v[j].x, v[j].y); o.y = pk2(v[j].z, v[j].w);
            *(GAS u32x2*)(UAUG + ((size_t)g * BC + b * NCH + c) * UA + s * 16 + h0) = o; }
    }
}
__device__ __forceinline__ void phase_final(Frame& F) {
    float* X = F.out; const float* nw = F.in[22];
    const int gw = F.bid * NWAVES + F.wave, NGW = F.G * NWAVES;
    for (int m = gw; m < T; m += NGW) {
        f32x4 v[4]; normmod_row(X + (size_t)m * D, nw, nullptr, nullptr, F.lane, v);
        GAS f32x4* o = (GAS f32x4*)(X + (size_t)m * D) + F.lane;
#pragma unroll
        for (int j = 0; j < 4; ++j) o[64 * j] = v[j];
    }
}
__device__ __forceinline__ void phase_scan(Frame& F) {
    const float* a_re = F.in[6]; const float* a_im = F.in[7]; const float* log_dt = F.in[8];
    const float* SLOC = (const float*)(F.ws + WS_SLOC); bf16_t* UAUG = (bf16_t*)(F.ws + WS_UAUG);
    LAS float* ends = (LAS float*)F.lds;
    const int p = F.lane, w = F.wave; constexpr int SEG = NCH / NWAVES;
    for (int task = F.bid; task < G * NB; task += F.G) {
        const int g = task >> 2, b = task & 3;
        const double dt = exp((double)log_dt[g]), ar = a_re[g * P + p], ai = a_im[g * P + p];
        const double mag = exp(ar * dt * QC), ph = ai * dt * QC, magS = exp(ar * dt * QC * SEG), phS = ai * dt * QC * SEG;
        const float lr = (float)(mag * cos(ph)), li = (float)(mag * sin(ph)), sr_ = (float)(magS * cos(phS)), si_ = (float)(magS * sin(phS));
        const float* sl = SLOC + ((size_t)g * BC + b * NCH + w * SEG) * 128 + p; bf16_t* ua = UAUG + ((size_t)g * BC + b * NCH + w * SEG) * UA + UK + p;
        float lre[SEG], lim[SEG], sre[SEG], sim[SEG];
#pragma unroll
        for (int c = 0; c < SEG; ++c) { sre[c] = sl[(size_t)c * 128]; sim[c] = sl[(size_t)c * 128 + 64]; }
        float xr = 0.f, xi = 0.f;
#pragma unroll
        for (int c = 0; c < SEG; ++c) { lre[c] = xr; lim[c] = xi; const float nr = lr * xr - li * xi + sre[c], ni = lr * xi + li * xr + sim[c]; xr = nr; xi = ni; }
        __syncthreads();
        ends[(w * 64 + p) * 2] = xr; ends[(w * 64 + p) * 2 + 1] = xi;
        __syncthreads();
        float br = 0.f, bi = 0.f;
        for (int v = 0; v < w; ++v) { const float er = ends[(v * 64 + p) * 2], ei = ends[(v * 64 + p) * 2 + 1]; const float nr = sr_ * br - si_ * bi + er, ni = sr_ * bi + si_ * br + ei; br = nr; bi = ni; }
#pragma unroll
        for (int c = 0; c < SEG; ++c) { const float orr = lre[c] + br, oi = lim[c] + bi;
            ua[(size_t)c * UA] = (bf16_t)f2bf(orr); ua[(size_t)c * UA + 64] = (bf16_t)f2bf(oi);
            const float nr = lr * br - li * bi, ni = lr * bi + li * br; br = nr; bi = ni; }
    }
    __syncthreads();
}

struct ProbBase { pg8::StaticOrder S; __device__ __forceinline__ bool next(int i, Unit& u) const { return S.next(i, u); } __device__ __forceinline__ void prep(LAS unsigned char*) const {} };
struct ProbGrouped { int c; __device__ __forceinline__ bool next(int i, Unit& u) const { if (i > 0) return false; u.pm = c & 3; u.pn = c >> 2; return true; } __device__ __forceinline__ void prep(LAS unsigned char*) const {} };
struct ProbSloc : ProbGrouped {
    static constexpr bool PERM = false; int K, ldb; size_t a_kstep, a_hstep; const bf16_t* UAUG; const bf16_t* WST; float* SLOC;
    __device__ __forceinline__ unsigned a_voff(int R, int C) const { return (unsigned)(R * UA + C) * 2u; }
    __device__ __forceinline__ const char* a_base(const Unit& u) const { return (const char*)(UAUG + ((size_t)u.pn * BC + u.pm * 256) * UA); }
    __device__ __forceinline__ const char* b_base(const Unit& u) const { return (const char*)(WST + (size_t)u.pn * 128 * UK); }
    __device__ __forceinline__ void epi(const AccT& acc, const Unit& u, int ui, LAS unsigned char* lds, int wr, int wc, int fr, int fq) const {
#pragma unroll
        for (int ai = 0; ai < 2; ++ai)
#pragma unroll
            for (int m = 0; m < 4; ++m) { const int row = u.pm * 256 + ai * 128 + wr * 64 + m * 16 + fr; float* rp = SLOC + ((size_t)u.pn * BC + row) * 128 + wc * 32 + 4 * fq;
#pragma unroll
                for (int n = 0; n < 2; ++n) *(f32x4*)(rp + n * 16) = acc[ai][0][m][n]; }
    }
};
struct ProbY : ProbGrouped {
    static constexpr bool PERM = true; int K, ldb; size_t a_kstep, a_hstep; const bf16_t* UAUG; const bf16_t* TT; bf16_t* ZT;
    __device__ __forceinline__ unsigned a_voff(int R, int C) const { return (unsigned)(R * UA + C) * 2u; }
    __device__ __forceinline__ const char* a_base(const Unit& u) const { return (const char*)(UAUG + ((size_t)u.pn * BC + u.pm * 256) * UA); }
    __device__ __forceinline__ const char* b_base(const Unit& u) const { return (const char*)(TT + (size_t)u.pn * 256 * UA); }
    __device__ __forceinline__ void epi(const AccT& acc, const Unit& u, int ui, LAS unsigned char* lds, int wr, int wc, int fr, int fq) const {
#pragma unroll
        for (int ai = 0; ai < 2; ++ai)
#pragma unroll
            for (int m = 0; m < 4; ++m) { const int row = u.pm * 256 + ai * 128 + wr * 64 + m * 16 + fr; bf16_t* rp = ZT + (size_t)u.pn * T * 16 + (size_t)row * 256 + wc * 32 + 8 * fq;
#pragma unroll
                for (int bj = 0; bj < 2; ++bj) { const f32x4 v0 = acc[ai][bj][m][0], v1 = acc[ai][bj][m][1]; u32x4 w;
                    w.x = cvt_pk_bf16(fast_gelu_tanh(v0[0]), fast_gelu_tanh(v0[1])); w.y = cvt_pk_bf16(fast_gelu_tanh(v0[2]), fast_gelu_tanh(v0[3]));
                    w.z = cvt_pk_bf16(fast_gelu_tanh(v1[0]), fast_gelu_tanh(v1[1])); w.w = cvt_pk_bf16(fast_gelu_tanh(v1[2]), fast_gelu_tanh(v1[3]));
                    *(u32x4*)(rp + bj * 128) = w; } }
    }
};
struct ProbGLU : ProbBase {
    static constexpr bool PERM = false; int K, ldb; size_t a_kstep, a_hstep; const bf16_t* ZT; const bf16_t* W; const float* xin; float* X; const float* gt  ; bf16_t* XB; float* SS; const float* nw; const float* sc  ;
    __device__ __forceinline__ unsigned a_voff(int R, int C) const { return (unsigned)((C >> 4) * T * 32 + R * 32 + (C & 15) * 2); }
    __device__ __forceinline__ const char* a_base(const Unit& u) const { return (const char*)ZT + (size_t)u.pm * 256 * 32; }
    __device__ __forceinline__ const char* b_base(const Unit& u) const { return (const char*)(W + (size_t)u.pn * 256 * D); }
    __device__ __forceinline__ void epi(const AccT& acc, const Unit& u, int ui, LAS unsigned char* lds, int wr, int wc, int fr, int fq) const {
        const int b = u.pm >> 4, col0 = u.pn * 128 + wc * 32 + 4 * fq; f32x4 gv[2], sv[2];
#pragma unroll
        for (int n = 0; n < 2; ++n) { gv[n] = *(const f32x4*)(gt + (size_t)b * 6 * D + col0 + n * 16); sv[n] = *(const f32x4*)(nw + col0 + n * 16) * (1.f + *(const f32x4*)(sc + (size_t)b * 6 * D + col0 + n * 16)); }
#pragma unroll
        for (int ai = 0; ai < 2; ++ai)
#pragma unroll
            for (int mp = 0; mp < 2; ++mp) {
                f32x4 xv[2][2];
#pragma unroll
                for (int mm = 0; mm < 2; ++mm)
#pragma unroll
                    for (int n = 0; n < 2; ++n) xv[mm][n] = *(const f32x4*)(xin + (size_t)(u.pm * 256 + ai * 128 + wr * 64 + (2 * mp + mm) * 16 + fr) * D + col0 + n * 16);
#pragma unroll
                for (int mm = 0; mm < 2; ++mm) { const int m = 2 * mp + mm, row = u.pm * 256 + ai * 128 + wr * 64 + m * 16 + fr; const size_t off = (size_t)row * D + col0; float rq = 0.f;
#pragma unroll
                    for (int n = 0; n < 2; ++n) { const f32x4 val = acc[ai][0][m][n], gate = acc[ai][1][m][n]; f32x4 o;
                        o[0] = xv[mm][n][0] + gv[n][0] * val[0] * fast_sigmoid(gate[0]); o[1] = xv[mm][n][1] + gv[n][1] * val[1] * fast_sigmoid(gate[1]);
                        o[2] = xv[mm][n][2] + gv[n][2] * val[2] * fast_sigmoid(gate[2]); o[3] = xv[mm][n][3] + gv[n][3] * val[3] * fast_sigmoid(gate[3]);
                        *(f32x4*)(X + off + n * 16) = o; rq += (o[0] * o[0] + o[1] * o[1]) + (o[2] * o[2] + o[3] * o[3]);
                        const f32x4 xs = o * sv[n]; u32x2 w2; w2.x = cvt_pk_bf16(xs[0], xs[1]); w2.y = cvt_pk_bf16(xs[2], xs[3]); *(u32x2*)(XB + off + n * 16) = w2; }
                    SS[(size_t)row * SSL + u.pn * 4 + wc] = sum_groups16(rq); }
                asm volatile("" ::: "memory"); }
    }
};
struct ProbPlain : ProbBase {
    int K, ldb, lda; size_t a_kstep, a_hstep; const bf16_t* A; const bf16_t* W;
    __device__ __forceinline__ unsigned a_voff(int R, int C) const { return (unsigned)(R * lda + C) * 2u; }
    __device__ __forceinline__ const char* a_base(const Unit& u) const { return (const char*)(A + (size_t)u.pm * 256 * lda); }
    __device__ __forceinline__ const char* b_base(const Unit& u) const { return (const char*)(W + (size_t)u.pn * 256 * ldb); }
};
constexpr int EPI_LDS = pg8::STAGE_BYTES;
template <int ACT  > struct ProbBf16Out : ProbPlain {
    static constexpr bool PERM = true; bf16_t* O; int ldc; const float* SS; int nslot; const float* bias  ;
    __device__ __forceinline__ void prep(LAS unsigned char* lds) const {
        LAS float* rl = (LAS float*)(lds + EPI_LDS); LAS float* bl = rl + 4 * 256; const int tid = threadIdx.x; Unit u;
#pragma unroll
        for (int i = 0; i < 4; ++i) if (S.next(i, u)) {
            if (tid < 256) { const f32x4* sp = (const f32x4*)(SS + (size_t)(u.pm * 256 + tid) * SSL); f32x4 a4 = sp[0];
                for (int q = 1; q < nslot / 4; ++q) a4 += sp[q];
                rl[i * 256 + tid] = 1.0f / sqrtf(((a4[0] + a4[1]) + (a4[2] + a4[3])) * (1.f / D) + EPS); }
            else bl[i * 256 + tid - 256] = bias[(size_t)(u.pm >> 4) * ldc + u.pn * 256 + tid - 256]; }
        __syncthreads();
    }
    __device__ __forceinline__ void epi(const AccT& acc, const Unit& u, int ui, LAS unsigned char* lds, int wr, int wc, int fr, int fq) const {
        const LAS float* rl = (const LAS float*)(lds + EPI_LDS) + ui * 256 + wr * 64 + fr; const LAS float* bl = (const LAS float*)(lds + EPI_LDS) + 4 * 256 + ui * 256 + wc * 32 + 8 * fq;
        const int row0 = u.pm * 256 + wr * 64 + fr, colb = u.pn * 256 + wc * 32 + 8 * fq;
        f32x4 bv[2][2];
#pragma unroll
        for (int bj = 0; bj < 2; ++bj) { bv[bj][0] = *(const LAS f32x4*)(bl + bj * 128); bv[bj][1] = *(const LAS f32x4*)(bl + bj * 128 + 4); }
#pragma unroll
        for (int ai = 0; ai < 2; ++ai)
#pragma unroll
            for (int m = 0; m < 4; ++m) { bf16_t* rp = O + (size_t)(row0 + ai * 128 + m * 16) * ldc + colb; const float rs = rl[ai * 128 + m * 16];
#pragma unroll
                for (int bj = 0; bj < 2; ++bj) { f32x4 v0 = acc[ai][bj][m][0] * rs + bv[bj][0], v1 = acc[ai][bj][m][1] * rs + bv[bj][1];
                    if (ACT == 1) { v0 = __builtin_elementwise_max(v0, (f32x4){0.f, 0.f, 0.f, 0.f}); v1 = __builtin_elementwise_max(v1, (f32x4){0.f, 0.f, 0.f, 0.f}); v0 = v0 * v0; v1 = v1 * v1; }
                    u32x4 w; w.x = cvt_pk_bf16(v0[0], v0[1]); w.y = cvt_pk_bf16(v0[2], v0[3]); w.z = cvt_pk_bf16(v1[0], v1[1]); w.w = cvt_pk_bf16(v1[2], v1[3]);
                    *(u32x4*)(rp + bj * 128) = w; } }
    }
};
struct ProbResid : ProbPlain {
    static constexpr bool PERM = false; float* X; const float* gt; bf16_t* XB; float* SS; const float* nw; const float* sc;
    __device__ __forceinline__ void epi(const AccT& acc, const Unit& u, int ui, LAS unsigned char* lds, int wr, int wc, int fr, int fq) const {
        const int b = u.pm >> 4, col0 = u.pn * 256 + wc * 32 + 4 * fq; f32x4 gv[2][2], sv[2][2];
#pragma unroll
        for (int bj = 0; bj < 2; ++bj)
#pragma unroll
            for (int n = 0; n < 2; ++n) { gv[bj][n] = *(const f32x4*)(gt + (size_t)b * 6 * D + col0 + bj * 128 + n * 16);
                sv[bj][n] = XB ? *(const f32x4*)(nw + col0 + bj * 128 + n * 16) * (1.f + *(const f32x4*)(sc + (size_t)b * 6 * D + col0 + bj * 128 + n * 16)) : (f32x4){0.f, 0.f, 0.f, 0.f}; }
#pragma unroll
        for (int ai = 0; ai < 2; ++ai)
#pragma unroll
            for (int mp = 0; mp < 2; ++mp) {
                f32x4 xv[2][2][2];
#pragma unroll
                for (int mm = 0; mm < 2; ++mm)
#pragma unroll
                    for (int bj = 0; bj < 2; ++bj)
#pragma unroll
                        for (int n = 0; n < 2; ++n) xv[mm][bj][n] = *(const f32x4*)(X + (size_t)(u.pm * 256 + ai * 128 + wr * 64 + (2 * mp + mm) * 16 + fr) * D + col0 + bj * 128 + n * 16);
#pragma unroll
                for (int mm = 0; mm < 2; ++mm) { const int m = 2 * mp + mm, row = u.pm * 256 + ai * 128 + wr * 64 + m * 16 + fr; const size_t off = (size_t)row * D + col0; float rq = 0.f;
#pragma unroll
                    for (int bj = 0; bj < 2; ++bj)
#pragma unroll
                        for (int n = 0; n < 2; ++n) { const f32x4 o = xv[mm][bj][n] + gv[bj][n] * acc[ai][bj][m][n]; *(f32x4*)(X + off + bj * 128 + n * 16) = o;
                            if (XB) { rq += (o[0] * o[0] + o[1] * o[1]) + (o[2] * o[2] + o[3] * o[3]);
                                const f32x4 xs = o * sv[bj][n]; u32x2 w2; w2.x = cvt_pk_bf16(xs[0], xs[1]); w2.y = cvt_pk_bf16(xs[2], xs[3]); *(u32x2*)(XB + off + bj * 128 + n * 16) = w2; } }
                    if (XB) SS[(size_t)row * SSL + u.pn * 4 + wc] = sum_groups16(rq); }
                asm volatile("" ::: "memory"); }
    }
};

__device__ __forceinline__ float fast_logsigmoid(float a) {
    const float e = __builtin_amdgcn_exp2f(-1.4426950408889634f * __builtin_fabsf(a));
    return fminf(a, 0.f) - 0.6931471805599453f * __builtin_amdgcn_logf(1.f + e);
}
__device__ __forceinline__ int img_off(int row, int ch) { return 256 * row + 16 * (ch ^ (((row & 3) << 2) | ((row >> 2) & 3))); }
typedef short v4i16_t __attribute__((ext_vector_type(4)));
__device__ __forceinline__ v4i16_t lds_tr16(const LAS unsigned char* p) { return __builtin_amdgcn_ds_read_tr16_b64_v4i16((LAS v4i16_t*)p); }
__device__ __forceinline__ void phase_gla_kdec(Frame& F) {
    const bf16_t* QKVR = (const bf16_t*)(F.ws + WS_QKVR); const float* w2 = F.in[16]; const float* bg = F.in[17];
    const bf16_t* XB = (const bf16_t*)(F.ws + WS_XBA); const bf16_t* WGT = (const bf16_t*)(F.ws + WS_WGT); const float* BG = (const float*)(F.ws + WS_BIASG); const float* SS = (const float*)(F.ws + WS_SS) + (size_t)T * SSL;
    bf16_t* KVF = (bf16_t*)(F.ws + WS_KVF); float* DEC = (float*)(F.ws + WS_DEC);
    LAS float* glr = (LAS float*)F.lds;
    constexpr int KP = QKW + 8, VP = DV + 8;
    LAS bf16_t* kt = (LAS bf16_t*)(F.lds + 4096);
    LAS bf16_t* vt = kt + 64 * KP;
    LAS float* gpart = (LAS float*)(vt + 64 * VP);
    const int j = F.tid, lane = F.lane, w = F.wave, g = lane >> 4, li = lane & 15, q4 = li >> 2, p4 = li & 3;
    float w2c[RANK];
#pragma unroll
    for (int r = 0; r < RANK; ++r) w2c[r] = w2[r * QKW + j];
    const float bgc = bg[j];
    for (int unit = F.bid; unit < NB * (SEQ / CH); unit += F.G) {
        const size_t m0 = (size_t)unit * CH;
        __syncthreads();
        {
            f32x4 ga[4];
#pragma unroll
            for (int mb = 0; mb < 4; ++mb) ga[mb] = (f32x4){0.f, 0.f, 0.f, 0.f};
#pragma unroll
            for (int ks = 0; ks < 4; ++ks) { const int k0 = 128 * w + 32 * ks + 8 * g; const bf16x8 bfr = *(const GAS bf16x8*)(WGT + li * D + k0);
#pragma unroll
                for (int mb = 0; mb < 4; ++mb) { const bf16x8 afr = *(const GAS bf16x8*)(XB + (m0 + 16 * mb + li) * D + k0); ga[mb] = __builtin_amdgcn_mfma_f32_16x16x32_bf16(afr, bfr, ga[mb], 0, 0, 0); } }
#pragma unroll
            for (int mb = 0; mb < 4; ++mb)
#pragma unroll
                for (int i = 0; i < 4; ++i) gpart[(w * 64 + 16 * mb + 4 * g + i) * 16 + li] = ga[mb][i];
        }
#pragma unroll
        for (int i = 0; i < 8; ++i) { const int idx = F.tid + NTHR * i, row = idx >> 6, ch = idx & 63;
            *(LAS u32x4*)(kt + row * KP + ch * 8) = *(const GAS u32x4*)(QKVR + (m0 + row) * NQKVR + QKW + ch * 8); }
        u32x4 rv[4];
#pragma unroll
        for (int i = 0; i < 4; ++i) { const int idx = F.tid + NTHR * i, row = idx >> 5, ch = idx & 31; rv[i] = *(const GAS u32x4*)(QKVR + (m0 + row) * NQKVR + 2 * QKW + ch * 8); }
        __syncthreads();
        { const int sIdx = F.tid >> 3, r2 = (F.tid & 7) * 2; float s0 = 0.f, s1 = 0.f;
#pragma unroll
            for (int v = 0; v < 8; ++v) { s0 += gpart[(v * 64 + sIdx) * 16 + r2]; s1 += gpart[(v * 64 + sIdx) * 16 + r2 + 1]; }
            const f32x4* sp = (const f32x4*)(SS + (m0 + sIdx) * SSL); const f32x4 a4 = (sp[0] + sp[1]) + (sp[2] + sp[3]);
            const float rs = 1.0f / sqrtf(((a4[0] + a4[1]) + (a4[2] + a4[3])) * (1.f / D) + EPS); const int bq = unit >> 6;
            glr[sIdx * 16 + r2] = s0 * rs + BG[bq * 16 + r2]; glr[sIdx * 16 + r2 + 1] = s1 * rs + BG[bq * 16 + r2 + 1]; }
        __syncthreads();
        { float gc[CH]; float run = 0.f;
#pragma unroll
            for (int s = 0; s < CH; ++s) { float a = bgc;
#pragma unroll
                for (int r4 = 0; r4 < 4; ++r4) { const f32x4 gv = *(const LAS f32x4*)(glr + s * 16 + r4 * 4); a += (gv.x * w2c[4 * r4] + gv.y * w2c[4 * r4 + 1]) + (gv.z * w2c[4 * r4 + 2] + gv.w * w2c[4 * r4 + 3]); }
                run += fast_logsigmoid(a) * (1.f / 16.f); gc[s] = run; }
#pragma unroll
            for (int s = 0; s < CH; ++s) { const float kv = bf2f(kt[s * KP + j]);
                kt[s * KP + j] = (bf16_t)f2bf(kv * __builtin_amdgcn_exp2f(1.4426950408889634f * (run - gc[s]))); }
            DEC[(size_t)unit * QKW + j] = __builtin_amdgcn_exp2f(1.4426950408889634f * run); }
#pragma unroll 1
        for (int hh = 0; hh < NH; ++hh) {
            __syncthreads();
#pragma unroll
            for (int i = 0; i < 4; ++i) { const int idx = F.tid + NTHR * i, row = idx >> 5, ch = idx & 31; *(LAS u32x4*)(vt + row * VP + ch * 8) = rv[i]; }
            if (hh + 1 < NH) {
#pragma unroll
                for (int i = 0; i < 4; ++i) { const int idx = F.tid + NTHR * i, row = idx >> 5, ch = idx & 31; rv[i] = *(const GAS u32x4*)(QKVR + (m0 + row) * NQKVR + 2 * QKW + (hh + 1) * DV + ch * 8); } }
            __syncthreads();
            f32x4 acc[2][8];
#pragma unroll
            for (int e = 0; e < 2; ++e)
#pragma unroll
                for (int dt = 0; dt < 8; ++dt) acc[e][dt] = (f32x4){0.f, 0.f, 0.f, 0.f};
#pragma unroll
            for (int ks = 0; ks < 2; ++ks) { const int r0 = 32 * ks + 8 * g + q4; bf16x8 vf[2];
#pragma unroll
                for (int e = 0; e < 2; ++e) { const v4i16_t lo = lds_tr16((const LAS unsigned char*)(vt + r0 * VP + 16 * (2 * w + e) + 4 * p4)), hi = lds_tr16((const LAS unsigned char*)(vt + (r0 + 4) * VP + 16 * (2 * w + e) + 4 * p4));
                    vf[e] = (bf16x8){lo[0], lo[1], lo[2], lo[3], hi[0], hi[1], hi[2], hi[3]}; }
#pragma unroll
                for (int dt = 0; dt < 8; ++dt) { const v4i16_t lo = lds_tr16((const LAS unsigned char*)(kt + r0 * KP + hh * DK + 16 * dt + 4 * p4)), hi = lds_tr16((const LAS unsigned char*)(kt + (r0 + 4) * KP + hh * DK + 16 * dt + 4 * p4));
                    const bf16x8 kf = (bf16x8){lo[0], lo[1], lo[2], lo[3], hi[0], hi[1], hi[2], hi[3]};
#pragma unroll
                    for (int e = 0; e < 2; ++e) acc[e][dt] = __builtin_amdgcn_mfma_f32_16x16x32_bf16(kf, vf[e], acc[e][dt], 0, 0, 0); } }
            bf16_t* kvo = KVF + ((size_t)(unit * NH + hh) * 16 + 2 * w) * 8 * 256 + lane * 4;
#pragma unroll
            for (int e = 0; e < 2; ++e)
#pragma unroll
                for (int dt = 0; dt < 8; ++dt) { u32x2 o; o.x = cvt_pk_bf16(acc[e][dt][0], acc[e][dt][1]); o.y = cvt_pk_bf16(acc[e][dt][2], acc[e][dt][3]); *(GAS u32x2*)(kvo + (e * 8 + dt) * 256) = o; }
        }
    }
    __syncthreads();
}
template <int ABL> __device__ __forceinline__ void phase_gla_scan(Frame& F) {
    if (F.bid >= NB * NH * 4) return;
    const bf16_t* QKVR = (const bf16_t*)(F.ws + WS_QKVR); const bf16_t* KVF = (const bf16_t*)(F.ws + WS_KVF); const float* DEC = (const float*)(F.ws + WS_DEC);
    bf16_t* OBUF = ABL ? (bf16_t*)(F.ws + WS_AOUT) : (bf16_t*)(F.ws + WS_QKVR) + 2 * QKW; constexpr int OP = ABL ? D : NQKVR; float* SSP = (float*)(F.ws + (ABL ? 240 * MiB : WS_SSP));
    const int unit = F.bid, b = unit >> 4, hh = (unit >> 2) & 3, eq = unit & 3;
    const int tid = F.tid, lane = F.lane, w = F.wave, eb = w & 3, dh = w >> 2, g = lane >> 4, li = lane & 15;
    constexpr int TILE = 16384, BUFB = TILE + 512, EXOFF = 2 * BUFB, EXB = 8 * 2048;
    LAS unsigned char* L = F.lds;
    int poff[2]; size_t gq[2];
#pragma unroll
    for (int i = 0; i < 2; ++i) { const int idx = tid + NTHR * i, row = idx >> 4, ch = idx & 15; poff[i] = img_off(row, ch); gq[i] = ((size_t)row * NQKVR + hh * DK) * 2 + ch * 16; }
    const size_t m00 = (size_t)b * SEQ;
    const bf16_t* kvbase = KVF + ((size_t)((b * (SEQ / CH)) * NH + hh) * 16 + eq * 4 + eb) * 8 * 256 + (size_t)(4 * dh) * 256 + lane * 4;
    u32x4 rqA[2], rqB[2]; u32x2 kvA[4], kvB[4]; f32x4 rdA = (f32x4){0.f, 0.f, 0.f, 0.f}, rdB = rdA;
#define GLA_LOAD(n, rq, kv, rd) do { const size_t m0_ = m00 + (size_t)(n) * CH; \
        _Pragma("unroll") for (int i = 0; i < 2; ++i) rq[i] = *(const GAS u32x4*)((const char*)QKVR + m0_ * NQKVR * 2 + gq[i]); \
        _Pragma("unroll") for (int dt = 0; dt < 4; ++dt) kv[dt] = *(const GAS u32x2*)(kvbase + (size_t)(n) * (NH * 16 * 8 * 256) + dt * 256); \
        if (tid < 32) rd = *(const GAS f32x4*)(DEC + ((size_t)b * (SEQ / CH) + (n)) * QKW + hh * DK + 4 * tid); } while (0)
#define GLA_WRITE(buf, rq, rd) do { LAS unsigned char* B_ = L + (buf) * BUFB; \
        _Pragma("unroll") for (int i = 0; i < 2; ++i) *(LAS u32x4*)(B_ + poff[i]) = rq[i]; \
        if (tid < 32) *(LAS f32x4*)(B_ + TILE + 16 * tid) = rd; } while (0)
    f32x4 S[4], keep[2];
#pragma unroll
    for (int dt = 0; dt < 4; ++dt) S[dt] = (f32x4){0.f, 0.f, 0.f, 0.f};
    keep[0] = keep[1] = (f32x4){0.f, 0.f, 0.f, 0.f};
    const int myslot = EXOFF + w * 2048 + lane * 16, paslot = EXOFF + (w ^ 4) * 2048 + lane * 16;
#define GLA_FINAL(nf) do { const size_t m0f = m00 + (size_t)(nf) * CH; \
        const f32x4 pr0 = *(const LAS f32x4*)(L + ((nf) & 1) * EXB + paslot), pr1 = *(const LAS f32x4*)(L + ((nf) & 1) * EXB + paslot + 1024); \
        _Pragma("unroll") for (int j = 0; j < 2; ++j) { const f32x4 acc = keep[j] + (j ? pr1 : pr0); const int c = 16 * (2 * dh + j) + li; \
            u32x2 o; o.x = cvt_pk_bf16(acc[0], acc[1]); o.y = cvt_pk_bf16(acc[2], acc[3]); \
            *(GAS u32x2*)(OBUF + (m0f + c) * OP + hh * DV + eq * 64 + 16 * eb + 4 * g) = o; \
            const float ss = sum_groups16((acc[0] * acc[0] + acc[1] * acc[1]) + (acc[2] * acc[2] + acc[3] * acc[3])); \
            if (g == 0) SSP[(m0f + c) * 64 + hh * 16 + eq * 4 + eb] = ss; } } while (0)
#define GLA_COMPUTE(n, kv) do { \
        const LAS unsigned char* Bq = L + ((n) & 1) * BUFB; const LAS float* Bd = (const LAS float*)(Bq + TILE); \
        u32x2 qf[4][2][2]; \
        _Pragma("unroll") for (int cb = 0; cb < 4; ++cb) _Pragma("unroll") for (int kk = 0; kk < 2; ++kk) { const int c = 16 * cb + li, chq = 8 * dh + 4 * kk + (g >> 1); \
            qf[cb][kk][0] = *(const LAS u32x2*)(Bq + img_off(c, chq) + 8 * (g & 1)); qf[cb][kk][1] = *(const LAS u32x2*)(Bq + img_off(c, chq + 2) + 8 * (g & 1)); } \
        _Pragma("unroll") for (int dt = 0; dt < 4; ++dt) { const f32x4 dc = *(const LAS f32x4*)(Bd + 16 * (4 * dh + dt) + 4 * g); \
            const f32x4 kvv = (f32x4){__builtin_bit_cast(float, kv[dt].x << 16), __builtin_bit_cast(float, kv[dt].x & 0xffff0000u), __builtin_bit_cast(float, kv[dt].y << 16), __builtin_bit_cast(float, kv[dt].y & 0xffff0000u)}; \
            S[dt] = S[dt] * dc + kvv; } \
        if ((n) > 0) GLA_FINAL((n) - 1); \
        bf16x8 sf[2]; \
        _Pragma("unroll") for (int kk = 0; kk < 2; ++kk) { u32x4 t; t.x = cvt_pk_bf16(S[2 * kk][0], S[2 * kk][1]); t.y = cvt_pk_bf16(S[2 * kk][2], S[2 * kk][3]); t.z = cvt_pk_bf16(S[2 * kk + 1][0], S[2 * kk + 1][1]); t.w = cvt_pk_bf16(S[2 * kk + 1][2], S[2 * kk + 1][3]); \
            sf[kk] = __builtin_bit_cast(bf16x8, t); } \
        f32x4 part[4]; \
        _Pragma("unroll") for (int cb = 0; cb < 4; ++cb) { f32x4 acc = (f32x4){0.f, 0.f, 0.f, 0.f}; \
            _Pragma("unroll") for (int kk = 0; kk < 2; ++kk) { u32x4 t; t.x = qf[cb][kk][0].x; t.y = qf[cb][kk][0].y; t.z = qf[cb][kk][1].x; t.w = qf[cb][kk][1].y; \
                acc = __builtin_amdgcn_mfma_f32_16x16x32_bf16(sf[kk], __builtin_bit_cast(bf16x8, t), acc, 0, 0, 0); } \
            part[cb] = acc; } \
        keep[0] = dh ? part[2] : part[0]; keep[1] = dh ? part[3] : part[1]; \
        *(LAS f32x4*)(L + ((n) & 1) * EXB + myslot) = dh ? part[0] : part[2]; *(LAS f32x4*)(L + ((n) & 1) * EXB + myslot + 1024) = dh ? part[1] : part[3]; } while (0)
    constexpr int NCK = SEQ / CH;
    GLA_LOAD(0, rqA, kvA, rdA); GLA_WRITE(0, rqA, rdA); GLA_LOAD(1, rqB, kvB, rdB); __syncthreads();
    u32x2 kvC[4];
    for (int n = 0; n < NCK; n += 2) {
#pragma unroll
        for (int dt = 0; dt < 4; ++dt) kvC[dt] = kvA[dt];
        if (ABL != 2 && n + 2 < NCK) GLA_LOAD(n + 2, rqA, kvA, rdA);
        if (ABL != 4) GLA_COMPUTE(n, kvC);
        if (ABL != 3) GLA_WRITE(1, rqB, rdB);
        WG_BAR();
#pragma unroll
        for (int dt = 0; dt < 4; ++dt) kvC[dt] = kvB[dt];
        if (ABL != 2 && n + 3 < NCK) GLA_LOAD(n + 3, rqB, kvB, rdB);
        if (ABL != 4) GLA_COMPUTE(n + 1, kvC);
        if (ABL != 3 && n + 2 < NCK) GLA_WRITE(0, rqA, rdA);
        WG_BAR();
    }
    GLA_FINAL(NCK - 1);
#undef GLA_LOAD
#undef GLA_WRITE
#undef GLA_COMPUTE
#undef GLA_FINAL
}
__device__ __forceinline__ void phase_gla_post(Frame& F) {
    const bf16_t* QKVR = (const bf16_t*)(F.ws + WS_QKVR); const float* gn = F.in[18]; bf16_t* AOUT = (bf16_t*)(F.ws + WS_AOUT); const float* SSP = (const float*)(F.ws + WS_SSP);
    const int gw = F.bid * NWAVES + F.wave, NGW = F.G * NWAVES;
    for (int m = gw; m < T; m += NGW) {
        float ssl = SSP[(size_t)m * 64 + F.lane];
        ssl += __shfl_xor(ssl, 1); ssl += __shfl_xor(ssl, 2); ssl += __shfl_xor(ssl, 4); ssl += __shfl_xor(ssl, 8);
        const GAS u32x2* o8 = (const GAS u32x2*)(QKVR + (size_t)m * NQKVR + 2 * QKW) + F.lane; const GAS u32x2* r8 = (const GAS u32x2*)(QKVR + (size_t)m * NQKVR + 2048) + F.lane;
        GAS u32x2* a8 = (GAS u32x2*)(AOUT + (size_t)m * D) + F.lane;
#pragma unroll
        for (int j = 0; j < 4; ++j) { const u32x2 ov = o8[64 * j], rv = r8[64 * j];
            const float o0 = bf2f(ov.x & 0xffff), o1 = bf2f(ov.x >> 16), o2 = bf2f(ov.y & 0xffff), o3 = bf2f(ov.y >> 16);
            const float r0 = bf2f(rv.x & 0xffff), r1 = bf2f(rv.x >> 16), r2 = bf2f(rv.y & 0xffff), r3 = bf2f(rv.y >> 16);
            const float ss = __shfl(ssl, 16 * j); const float rstd = 1.0f / sqrtf(ss * (1.f / DV) + EPS);
            const f32x4 g4 = ((const GAS f32x4*)gn)[F.lane + 64 * j];
            u32x2 wv; wv.x = pk2(o0 * rstd * g4.x * silu_f(r0), o1 * rstd * g4.y * silu_f(r1)); wv.y = pk2(o2 * rstd * g4.z * silu_f(r2), o3 * rstd * g4.w * silu_f(r3));
            a8[64 * j] = wv; }
    }
}

template <int PHX> __device__ __forceinline__ void run_phase(Frame& F) {
    constexpr int PH = PHX & 63;
    const float* MOD = (const float*)(F.ws + WS_MOD);
    const bf16_t* UAUG = (const bf16_t*)(F.ws + WS_UAUG);
    LAS unsigned char* ring = F.lds;
    float* Xp = (PHX & 64) ? (float*)(F.ws + (PH == 14 ? 64 * MiB : 192 * MiB)) : F.out;

    if constexpr (PH == 0) { phase_s5tables(F); phase_mod(F); }
    if constexpr (PH == 1) { phase_bias(F); phase_upass(F); phase_convert(F); }
    if constexpr (PH == 2) { ProbSloc Pb; Pb.c = F.bid; Pb.K = UK; Pb.ldb = UK; Pb.a_kstep = 128; Pb.a_hstep = (size_t)128 * UA * 2; Pb.UAUG = UAUG; Pb.WST = (const bf16_t*)(F.ws + WS_WST); Pb.SLOC = (float*)(F.ws + WS_SLOC);
            pg8::gemm_phase<ProbSloc, true, true>(ring, Pb); }
    if constexpr (PH == 3) { phase_scan(F); }
    if constexpr (PH == 4) { ProbY Pb; Pb.c = F.bid; Pb.K = UA; Pb.ldb = UA; Pb.a_kstep = 128; Pb.a_hstep = (size_t)128 * UA * 2; Pb.UAUG = UAUG; Pb.TT = (const bf16_t*)(F.ws + WS_TT); Pb.ZT = (bf16_t*)(F.ws + WS_ZT);
            pg8::gemm_phase<ProbY, true, true>(ring, Pb); }
    if constexpr (PH == 5) { ProbGLU Pb; Pb.S.init(T, 2 * D, F.G, F.bid); Pb.K = D; Pb.ldb = D; Pb.a_kstep = (size_t)4 * T * 32; Pb.a_hstep = 128 * 32; Pb.ZT = (const bf16_t*)(F.ws + WS_ZT); Pb.W = (const bf16_t*)(F.ws + WS_WGLU);
            Pb.xin = F.in[0]; Pb.X = Xp; Pb.gt = MOD + 2 * D; Pb.XB = (bf16_t*)(F.ws + WS_XBA); Pb.SS = (float*)(F.ws + WS_SS); Pb.nw = F.in[5]; Pb.sc = MOD + 4 * D;
            pg8::gemm_phase<ProbGLU, true, true>(ring, Pb); }
    if constexpr (PH == 7 || PH == 16) { constexpr int l = (PH == 16); ProbBf16Out<1> Pb; Pb.S.init(T, DFF, F.G, F.bid); Pb.K = D; Pb.ldb = D; Pb.lda = D; Pb.a_kstep = 128; Pb.a_hstep = (size_t)128 * D * 2; Pb.A = (const bf16_t*)(F.ws + (l ? WS_XBC : WS_XBA)); Pb.W = (const bf16_t*)(F.ws + WS_W1L(l));
            Pb.O = (bf16_t*)(F.ws + WS_A2); Pb.ldc = DFF; Pb.SS = (const float*)(F.ws + WS_SS) + (size_t)(l ? 2 : 0) * T * SSL; Pb.nslot = l ? 16 : 32; Pb.bias = (const float*)(F.ws + WS_BIAS1) + (size_t)l * NB * DFF;
            pg8::gemm_phase<ProbBf16Out<1>, true, true>(ring, Pb); }
    if constexpr (PH == 8 || PH == 17) { constexpr int l = (PH == 17); ProbResid Pb; Pb.S.init(T, D, F.G, F.bid); Pb.K = DFF; Pb.ldb = DFF; Pb.lda = DFF; Pb.a_kstep = 128; Pb.a_hstep = (size_t)128 * DFF * 2; Pb.A = (const bf16_t*)(F.ws + WS_A2); Pb.W = (const bf16_t*)(F.ws + WS_W2L(l));
            Pb.X = Xp; Pb.gt = MOD + (size_t)l * NB * 6 * D + 5 * D;
            if (l == 0 && !(PHX & 64)) { Pb.XB = (bf16_t*)(F.ws + WS_XBA); Pb.SS = (float*)(F.ws + WS_SS) + (size_t)T * SSL; Pb.nw = F.in[4] + D; Pb.sc = MOD + (size_t)NB * 6 * D + 1 * D; } else { Pb.XB = nullptr; Pb.SS = nullptr; Pb.nw = nullptr; Pb.sc = nullptr; }
            pg8::gemm_phase<ProbResid, true, true>(ring, Pb); }
    if constexpr (PH == 10) { ProbBf16Out<0> Pb; Pb.S.init(T, NQKVR, F.G, F.bid); Pb.K = D; Pb.ldb = D; Pb.lda = D; Pb.a_kstep = 128; Pb.a_hstep = (size_t)128 * D * 2; Pb.A = (const bf16_t*)(F.ws + WS_XBA); Pb.W = (const bf16_t*)(F.ws + WS_WIN);
            Pb.O = (bf16_t*)(F.ws + WS_QKVR); Pb.ldc = NQKVR; Pb.SS = (const float*)(F.ws + WS_SS) + (size_t)T * SSL; Pb.nslot = 16; Pb.bias = (const float*)(F.ws + WS_BIASIN);
            pg8::gemm_phase<ProbBf16Out<0>, true, true>(ring, Pb); }
    if constexpr (PH == 11) { phase_gla_kdec(F); }
    if constexpr (PH == 12) { phase_gla_scan<0>(F); }
    if constexpr (PH >= 41 && PH <= 45) { phase_gla_scan<PH - 40>(F); }
    if constexpr (PH == 13) { phase_gla_post(F); }
    if constexpr (PH == 14) { ProbResid Pb; Pb.S.init(T, D, F.G, F.bid); Pb.K = D; Pb.ldb = D; Pb.lda = D; Pb.a_kstep = 128; Pb.a_hstep = (size_t)128 * D * 2; Pb.A = (const bf16_t*)(F.ws + WS_AOUT); Pb.W = (const bf16_t*)(F.ws + WS_WOUT);
            Pb.X = Xp; Pb.gt = MOD + (size_t)NB * 6 * D + 2 * D;
            if (!(PHX & 64)) { Pb.XB = (bf16_t*)(F.ws + WS_XBC); Pb.SS = (float*)(F.ws + WS_SS) + (size_t)2 * T * SSL; Pb.nw = F.in[5] + D; Pb.sc = MOD + (size_t)NB * 6 * D + 4 * D; } else { Pb.XB = nullptr; Pb.SS = nullptr; Pb.nw = nullptr; Pb.sc = nullptr; }
            pg8::gemm_phase<ProbResid, true, true>(ring, Pb); }
    if constexpr (PH == 18) { phase_final(F); }
}
#ifndef PROG_LIST
#define PROG_LIST RUNB(0) RUNB(1) RUNB(2) RUNB(3) RUNB(4) RUNB(5) RUNB(7) RUNB(8) RUNB(10) RUNB(11) RUNB(12) RUNB(13) RUNB(14) RUNB(16) RUNB(17) RUNL(18)
#endif
__global__ void __launch_bounds__(NTHR, 2) mega_fwd(Args args) {
    extern __shared__ __attribute__((aligned(16))) unsigned char lds_raw[];
    Frame F; F.lds = (LAS unsigned char*)lds_raw; F.tid = threadIdx.x; F.lane = F.tid & 63; F.wave = __builtin_amdgcn_readfirstlane(F.tid >> 6);
    F.G = gridDim.x; F.bid = blockIdx.x; F.out = args.out; F.ws = args.ws;
#pragma unroll
    for (int i = 0; i < 23; ++i) F.in[i] = args.in[i];
    volatile LAS unsigned* MISC = (volatile LAS unsigned*)(F.lds + MISC_OFF);
    for (int u = F.tid; u < (LDS_BYTES - LDSCTL_OFF) / 4; u += NTHR) ((LAS unsigned*)(F.lds + LDSCTL_OFF))[u] = 0u;
    __syncthreads();
    XcdBarrier bar = xcd_barrier_post((unsigned*)(F.ws + WS_CTL) + CW_BAR, MISC + 8);
    const unsigned long long pmask = args.pmask; constexpr int cbase = __COUNTER__ + 1;
#define RUNB(k) if ((pmask >> (__COUNTER__ - cbase)) & 1ull) { run_phase<k>(F); } xcd_barrier(bar);
#define RUNL(k) if ((pmask >> (__COUNTER__ - cbase)) & 1ull) { run_phase<k>(F); }
    PROG_LIST
#undef RUNB
#undef RUNL
}

extern "C" void kernel_launch(void* const* d_in, const int* in_sizes, int n_in, void* d_out, int out_size, void* d_ws, size_t ws_size, hipStream_t stream) {
    static int grid = 0;
    if (grid == 0) {
        int dev = 0, cus = 0;
        if (n_in != 23 || out_size != T * D || ws_size < WS_END) { fprintf(stderr, "kernel_launch: unexpected shapes (n_in %d out %d ws %zu)\n", n_in, out_size, ws_size); grid = -1; return; }
        if (hipGetDevice(&dev) != hipSuccess || hipDeviceGetAttribute(&cus, hipDeviceAttributeMultiprocessorCount, dev) != hipSuccess) { grid = -1; return; }
        if (hipFuncSetAttribute((const void*)mega_fwd, hipFuncAttributeMaxDynamicSharedMemorySize, LDS_BYTES) != hipSuccess) { fprintf(stderr, "kernel_launch: hipFuncSetAttribute failed\n"); grid = -1; return; }
        int per_cu = 0;
        if (hipOccupancyMaxActiveBlocksPerMultiprocessor(&per_cu, (const void*)mega_fwd, NTHR, LDS_BYTES) != hipSuccess || per_cu < 1) fprintf(stderr, "kernel_launch: occupancy query reports %d\n", per_cu);
        (void)hipGetLastError();
        grid = cus;
        if (grid != 256) fprintf(stderr, "kernel_launch: %d CUs (built for 256)\n", grid);
    }
    if (grid < 0) return;
    (void)hipMemsetAsync((char*)d_ws + WS_CTL, 0, CTL_ZERO_BYTES, stream);
    Args a{};
    for (int i = 0; i < 23; ++i) a.in[i] = (const float*)d_in[i];
    a.out = (float*)d_out; a.ws = (unsigned char*)d_ws; a.pmask = ~0ull;
    hipLaunchKernelGGL(mega_fwd, dim3(grid), dim3(NTHR), LDS_BYTES, stream, a);
}
```

```cpp
#include <hip/hip_runtime.h>
#include <cstdio>
#include <cstdint>
#include <math.h>

#define LAS __attribute__((address_space(3)))
#define GAS __attribute__((address_space(1)))
typedef unsigned short bf16_t;
typedef short bf16x8 __attribute__((ext_vector_type(8)));
typedef float f32x4 __attribute__((ext_vector_type(4)));
typedef float f32x2 __attribute__((ext_vector_type(2)));
typedef unsigned u32x4 __attribute__((ext_vector_type(4)));
typedef unsigned u32x2 __attribute__((ext_vector_type(2)));

constexpr int NB = 4, SEQ = 4096, D = 1024, T = NB * SEQ;
constexpr int G = 64, P = 64, HG = 16;
constexpr int QC = 16, NCH = SEQ / QC, BC = NB * NCH;
constexpr int UK = QC * HG, UA = UK + 2 * P;
constexpr int NH = 4, DK = 128, DV = 256, QKW = 512, RANK = 16, GIN = 3088, DFF = 4096, CH = 64;
constexpr int NQKVR = 3072;
constexpr float EPS = 1e-6f;

constexpr size_t MiB = 1u << 20;
constexpr size_t WS_CTL = 0, CTL_ZERO_BYTES = 1 * MiB;
constexpr size_t WS_MOD = 1 * MiB;
constexpr size_t WS_GLR = 2 * MiB;
constexpr size_t WS_WGLU = 4 * MiB;
constexpr size_t WS_WIN = 8 * MiB;
constexpr size_t WS_WOUT = 14 * MiB;
constexpr size_t WS_W1 = 16 * MiB;
constexpr size_t WS_W2 = 32 * MiB;
constexpr size_t WS_TT = 48 * MiB;
constexpr size_t WS_WST = 60 * MiB;
constexpr size_t WS_UAUG = 64 * MiB;
constexpr size_t WS_SLOC = 112 * MiB;
constexpr size_t WS_ZT = 144 * MiB;
constexpr size_t WS_A2 = 64 * MiB;
constexpr size_t WS_QKVR = 64 * MiB;
constexpr size_t WS_KVF = 160 * MiB;
constexpr size_t WS_DEC = 3 * MiB;
constexpr size_t WS_SSP = 240 * MiB;
constexpr size_t WS_H = 208 * MiB;
constexpr size_t WS_AOUT = 208 * MiB;
constexpr size_t WS_END = 248 * MiB;
constexpr size_t WS_DUMMY = 64 * MiB;
constexpr int CW_BAR = 4096;

constexpr int LDS_BYTES = 147456, LDSCTL_OFF = LDS_BYTES - 512, MISC_OFF = LDSCTL_OFF + 320, RING_BYTES = LDSCTL_OFF;
constexpr int NWAVES = 8, NTHR = NWAVES * 64;

__device__ __forceinline__ unsigned f2bf(float f) { unsigned u = __builtin_bit_cast(unsigned, f); return (u + 0x7fffu + ((u >> 16) & 1u)) >> 16; }
__device__ __forceinline__ unsigned pk2(float lo, float hi) { return f2bf(lo) | (f2bf(hi) << 16); }
__device__ __forceinline__ float bf2f(unsigned short b) { return __builtin_bit_cast(float, (unsigned)b << 16); }
typedef __bf16 bf16x2_t __attribute__((ext_vector_type(2)));
__device__ __forceinline__ unsigned cvt_pk_bf16(float lo, float hi) { const f32x2 v = {lo, hi}; const bf16x2_t b = __builtin_convertvector(v, bf16x2_t); return __builtin_bit_cast(unsigned, b); }
__device__ __forceinline__ float fast_sigmoid(float x) { return __builtin_amdgcn_rcpf(1.f + __builtin_amdgcn_exp2f(-1.4426950408889634f * x)); }
__device__ __forceinline__ float fast_gelu_tanh(float x) { const float u = 0.7978845608028654f * (x + 0.044715f * x * x * x); return x * fast_sigmoid(2.f * u); }
__device__ __forceinline__ float silu_f(float x) { return x / (1.f + expf(-x)); }
__device__ __forceinline__ float logsigmoid_f(float x) { return fminf(x, 0.f) - log1pf(expf(-fabsf(x))); }
__device__ __forceinline__ float wave_sum(float v) {
#pragma unroll
    for (int o = 1; o < 64; o <<= 1) v += __shfl_xor(v, o);
    return v;
}
#define LDS_WAIT() asm volatile("s_waitcnt lgkmcnt(0)" ::: "memory")
#define WG_BAR() do { asm volatile("s_waitcnt lgkmcnt(0)" ::: "memory"); __builtin_amdgcn_s_barrier(); asm volatile("" ::: "memory"); } while (0)
#define VM_WAIT() asm volatile("s_waitcnt vmcnt(0)" ::: "memory")

namespace pg8 {
constexpr int BM = 256, BK = 64, HALF = 128, HTB = HALF * BK * 2, STAGE_BYTES = 8 * HTB, NXCD = 8, WGM = 8;
__host__ __device__ __forceinline__ int lds_byte(int r, int c) { const int st = (r >> 4) * 2 + (c >> 5), rr = r & 15, cc = c & 31, ob = rr * 64 + cc * 2; return st * 1024 + (ob ^ (((ob >> 9) & 1) << 5)); }
__host__ __device__ __forceinline__ void stage_rc(int b, int& R, int& C) { const int st = b / 1024, sb = b % 1024, swz = sb ^ (((sb >> 9) & 1) << 5); R = (st >> 1) * 16 + swz / 64; C = (st & 1) * 32 + (swz % 64) / 2; }
__host__ __device__ __forceinline__ int perm32(int rho) { const int n = rho >> 4, i = rho & 15; return 8 * (i >> 2) + 4 * n + (i & 3); }
struct Unit { int pm, pn; };
struct StaticOrder {
    int nM, nN, nwg, G, c;
    __device__ void init(int M, int N, int G_, int c_) { nM = M / BM; nN = N / BM; nwg = nM * nN; G = G_; c = c_; }
    __device__ bool next(int i, Unit& u) const {
        const long L = (long)i * G + c; if (L >= nwg) return false;
        int wgid = (int)L; { const int q = nwg / NXCD, r = nwg % NXCD, xcd = wgid % NXCD, off = wgid / NXCD; wgid = (xcd < r ? xcd * (q + 1) : r * (q + 1) + (xcd - r) * q) + off; }
        const int nig = WGM * nN, gid = wgid / nig, fm = gid * WGM, gsz = (nM - fm) < WGM ? (nM - fm) : WGM;
        u.pm = fm + ((wgid % nig) % gsz); u.pn = (wgid % nig) / gsz; return true;
    }
};
template <class Prob, bool ALIGN_EPI, bool SP2>
__device__ __forceinline__ void gemm_phase(LAS unsigned char* lds, const Prob& Pb) {
    const int tid = threadIdx.x, wid = __builtin_amdgcn_readfirstlane(tid >> 6), lane = tid & 63, wr = wid >> 2, wc = wid & 3, fr = lane & 15, fq = lane >> 4;
    const int K = Pb.K, nt = K / BK;
    unsigned voffA[2], voffB[2];
#pragma unroll
    for (int i = 0; i < 2; ++i) { int R, C; stage_rc(tid * 16 + i * 8192, R, C); const int Rb = Prob::PERM ? ((R & ~31) + perm32(R & 31)) : R;
        voffA[i] = Pb.a_voff(R, C); voffB[i] = (unsigned)(Rb * Pb.ldb + C) * 2u; }
    const size_t kstepA = Pb.a_kstep, hstepA = Pb.a_hstep, kstepB = (size_t)(BK * 2), hstepB = (size_t)HALF * Pb.ldb * 2;
    const unsigned ldsw = (unsigned)wid * 1024u;
    const int aoff = lds_byte(wr * 64 + fr, fq * 8), boff = lds_byte(wc * 32 + fr, fq * 8);
#define PG8_SA(b, h) (((b) * 2 + (h)) * HTB)
#define PG8_SB(b, h) ((4 + (b) * 2 + (h)) * HTB)
#define PG8_STAGE(bufoff, gbase, voff) do { _Pragma("unroll") for (int _i = 0; _i < 2; ++_i) \
        __builtin_amdgcn_global_load_lds((const unsigned*)((const char*)(gbase) + (voff)[_i]), (LAS unsigned*)(lds + (bufoff) + ldsw + _i * 8192), 16, 0, 0); } while (0)
#define PG8_LDA(dst, b, h) do { _Pragma("unroll") for (int m = 0; m < 4; ++m) _Pragma("unroll") for (int k = 0; k < 2; ++k) dst[m][k] = *(const LAS bf16x8*)(lds + PG8_SA(b, h) + aoff + m * 2048 + k * 1024); } while (0)
#define PG8_LDB(dst, b, h) do { _Pragma("unroll") for (int n = 0; n < 2; ++n) _Pragma("unroll") for (int k = 0; k < 2; ++k) dst[n][k] = *(const LAS bf16x8*)(lds + PG8_SB(b, h) + boff + n * 2048 + k * 1024); } while (0)
#define PG8_MMA(ai, bj, At, Bt) do { __builtin_amdgcn_s_setprio(1); _Pragma("unroll") for (int m = 0; m < 4; ++m) _Pragma("unroll") for (int n = 0; n < 2; ++n) _Pragma("unroll") for (int k = 0; k < 2; ++k) \
        acc[ai][bj][m][n] = __builtin_amdgcn_mfma_f32_16x16x32_bf16(Bt[n][k], At[m][k], acc[ai][bj][m][n], 0, 0, 0); __builtin_amdgcn_s_setprio(0); } while (0)
#define PG8_WAIT_V(n) asm volatile("s_waitcnt vmcnt(" #n ")" ::: "memory")
#define PG8_WAIT_L(n) asm volatile("s_waitcnt lgkmcnt(" #n ")" ::: "memory")
#define PG8_BAR __builtin_amdgcn_s_barrier()
#define PG8_SCHED __builtin_amdgcn_sched_barrier(0)
    Unit cur, nxt; int ui = 0;
    if (!Pb.next(0, cur)) return;
    f32x4 acc[2][2][4][2];
#pragma unroll
    for (int a = 0; a < 2; ++a)
#pragma unroll
        for (int b = 0; b < 2; ++b)
#pragma unroll
            for (int m = 0; m < 4; ++m)
#pragma unroll
                for (int n = 0; n < 2; ++n) acc[a][b][m][n] = (f32x4){0.f, 0.f, 0.f, 0.f};
    bf16x8 At[4][2], B0[2][2], B1[2][2];
    const char* cA = Pb.a_base(cur); const char* cB = Pb.b_base(cur);
    if constexpr (SP2) {
        PG8_STAGE(PG8_SB(0, 0), cB, voffB); PG8_STAGE(PG8_SB(0, 1), cB + hstepB, voffB); PG8_STAGE(PG8_SA(0, 0), cA, voffA); PG8_STAGE(PG8_SA(0, 1), cA + hstepA, voffA);
        if (wr == 1) PG8_BAR;
        PG8_WAIT_V(2); PG8_BAR;
        PG8_STAGE(PG8_SB(1, 0), cB + kstepB, voffB); PG8_STAGE(PG8_SA(1, 0), cA + kstepA, voffA); PG8_STAGE(PG8_SB(1, 1), cB + hstepB + kstepB, voffB);
        PG8_WAIT_V(6); PG8_BAR;
    } else {
        PG8_STAGE(PG8_SB(0, 0), cB, voffB); PG8_STAGE(PG8_SA(0, 0), cA, voffA); PG8_STAGE(PG8_SB(0, 1), cB + hstepB, voffB); PG8_STAGE(PG8_SA(0, 1), cA + hstepA, voffA);
        if (wr == 1) PG8_BAR;
        PG8_WAIT_V(4); PG8_BAR;
        PG8_STAGE(PG8_SB(1, 0), cB + kstepB, voffB); PG8_STAGE(PG8_SA(1, 0), cA + kstepA, voffA); PG8_STAGE(PG8_SB(1, 1), cB + hstepB + kstepB, voffB);
        PG8_WAIT_V(6); PG8_BAR;
    }
    for (;;) {
        const bool has_next = Pb.next(ui + 1, nxt);
        const char* nA = has_next ? Pb.a_base(nxt) : cA; const char* nB = has_next ? Pb.b_base(nxt) : cB;
        for (int t = 0; t < nt; t += 2) {
            const bool last = (t == nt - 2);
            const char* a1 = cA + (size_t)(t + 1) * kstepA;
            const char* a2 = last ? nA : cA + (size_t)(t + 2) * kstepA; const char* b2 = last ? nB : cB + (size_t)(t + 2) * kstepB;
            const char* a3 = a2 + kstepA; const char* b3 = b2 + kstepB;
            if constexpr (SP2) {
            PG8_LDB(B0, 0, 0); PG8_LDB(B1, 0, 1); PG8_SCHED; PG8_LDA(At, 0, 0); PG8_STAGE(PG8_SA(1, 1), a1 + hstepA, voffA);
            PG8_WAIT_V(8); PG8_WAIT_L(0); PG8_BAR; PG8_MMA(0, 0, At, B0); PG8_MMA(0, 1, At, B1); PG8_BAR; PG8_SCHED;
            PG8_LDA(At, 0, 1); PG8_STAGE(PG8_SB(0, 0), b2, voffB); PG8_STAGE(PG8_SB(0, 1), b2 + hstepB, voffB); PG8_STAGE(PG8_SA(0, 0), a2, voffA);
            PG8_WAIT_V(8); PG8_WAIT_L(0); PG8_BAR; PG8_MMA(1, 0, At, B0); PG8_MMA(1, 1, At, B1); PG8_BAR; PG8_SCHED;
            PG8_LDB(B0, 1, 0); PG8_LDB(B1, 1, 1); PG8_SCHED; PG8_LDA(At, 1, 0); PG8_STAGE(PG8_SA(0, 1), a2 + hstepA, voffA);
            PG8_WAIT_V(8); PG8_WAIT_L(0); PG8_BAR; PG8_MMA(0, 0, At, B0); PG8_MMA(0, 1, At, B1); PG8_BAR; PG8_SCHED;
            PG8_LDA(At, 1, 1); PG8_STAGE(PG8_SB(1, 0), b3, voffB); PG8_STAGE(PG8_SB(1, 1), b3 + hstepB, voffB); PG8_STAGE(PG8_SA(1, 0), a3, voffA);
            PG8_WAIT_V(8); PG8_WAIT_L(0); PG8_BAR; PG8_MMA(1, 0, At, B0); PG8_MMA(1, 1, At, B1); PG8_BAR; PG8_SCHED;
            } else {
            PG8_LDB(B0, 0, 0); PG8_SCHED; PG8_LDA(At, 0, 0); PG8_STAGE(PG8_SA(1, 1), a1 + hstepA, voffA);
            PG8_WAIT_L(8); PG8_BAR; PG8_WAIT_L(0); PG8_MMA(0, 0, At, B0); PG8_BAR; PG8_SCHED;
            PG8_LDB(B1, 0, 1); PG8_STAGE(PG8_SB(0, 0), b2, voffB);
            PG8_BAR; PG8_WAIT_L(0); PG8_MMA(0, 1, At, B1); PG8_BAR;
            PG8_LDA(At, 0, 1); PG8_STAGE(PG8_SA(0, 0), a2, voffA);
            PG8_BAR; PG8_WAIT_L(0); PG8_MMA(1, 0, At, B0); PG8_BAR; PG8_SCHED;
            PG8_STAGE(PG8_SB(0, 1), b2 + hstepB, voffB);
            PG8_WAIT_V(6); PG8_BAR; PG8_MMA(1, 1, At, B1); PG8_BAR;
            PG8_LDB(B0, 1, 0); PG8_SCHED; PG8_LDA(At, 1, 0); PG8_STAGE(PG8_SA(0, 1), a2 + hstepA, voffA);
            PG8_WAIT_L(8); PG8_BAR; PG8_WAIT_L(0); PG8_MMA(0, 0, At, B0); PG8_BAR; PG8_SCHED;
            PG8_LDB(B1, 1, 1); PG8_STAGE(PG8_SB(1, 0), b3, voffB);
            PG8_BAR; PG8_WAIT_L(0); PG8_MMA(0, 1, At, B1); PG8_BAR;
            PG8_LDA(At, 1, 1); PG8_STAGE(PG8_SA(1, 0), a3, voffA);
            PG8_BAR; PG8_WAIT_L(0); PG8_MMA(1, 0, At, B0); PG8_BAR; PG8_SCHED;
            PG8_STAGE(PG8_SB(1, 1), b3 + hstepB, voffB);
            PG8_WAIT_V(6); PG8_BAR; PG8_MMA(1, 1, At, B1); PG8_BAR;
            }
        }
        if constexpr (ALIGN_EPI) { if (wr == 0) PG8_BAR; }
        Pb.epi(acc, cur, wr, wc, fr, fq);
        if (!has_next) break;
#pragma unroll
        for (int a = 0; a < 2; ++a)
#pragma unroll
            for (int b = 0; b < 2; ++b)
#pragma unroll
                for (int m = 0; m < 4; ++m)
#pragma unroll
                    for (int n = 0; n < 2; ++n) acc[a][b][m][n] = (f32x4){0.f, 0.f, 0.f, 0.f};
        cur = nxt; cA = nA; cB = nB; ++ui;
        if constexpr (ALIGN_EPI) { if (wr == 1) PG8_BAR; }
    }
    PG8_WAIT_V(0);
    if constexpr (!ALIGN_EPI) { if (wr == 0) PG8_BAR; }
    PG8_BAR;
#undef PG8_SA
#undef PG8_SB
#undef PG8_STAGE
#undef PG8_LDA
#undef PG8_LDB
#undef PG8_MMA
#undef PG8_WAIT_V
#undef PG8_WAIT_L
#undef PG8_BAR
#undef PG8_SCHED
}
}
using pg8::Unit;
typedef f32x4 AccT[2][2][4][2];

#define XB_TMO      128
#define XB_XCNT(j)  (256  + 64 * (j))
#define XB_XSUB(j)  (1280 + 64 * (j))
#define XB_XGEN(j)  (2304 + 64 * (j))
#define XB_TOP      3328
#define XB_TOPGEN   3392
#define XCD_BAR_WORDS 3456
#define XB_SPIN_CAP (1u << 18)
__device__ __forceinline__ unsigned xb_ld(unsigned* p)              { return __hip_atomic_load(p, __ATOMIC_RELAXED, __HIP_MEMORY_SCOPE_AGENT); }
__device__ __forceinline__ unsigned xb_add(unsigned* p, unsigned v) { return __hip_atomic_fetch_add(p, v, __ATOMIC_RELAXED, __HIP_MEMORY_SCOPE_AGENT); }
__device__ __forceinline__ unsigned xb_xcc_id() { return (unsigned)__builtin_amdgcn_s_getreg((3 << 11) | 20) & 0xFu; }
#define XB_SPIN(cond, bar) do { unsigned _sp = 0; while (cond) { __builtin_amdgcn_s_sleep(1); \
    if ((++_sp & 255u) == 0u) { if (xb_ld(&(bar)[XB_TMO])) break; if (_sp > XB_SPIN_CAP) { atomicAdd(&(bar)[XB_TMO], 1u); break; } } } } while (0)
struct XcdBarrier { unsigned* bar; unsigned x; volatile LAS unsigned* st; };
__device__ __forceinline__ XcdBarrier xcd_barrier_post(unsigned* bar, volatile LAS unsigned* st) {
    XcdBarrier b; b.bar = bar; b.x = xb_xcc_id(); b.st = st;
    if (threadIdx.x == 0) (void)xb_add(&bar[XB_XCNT(b.x)], 1u);
    return b;
}
__device__ __forceinline__ void xcd_barrier_complete(unsigned* bar, unsigned x, unsigned& nloc, unsigned& nx) {
    const unsigned Gn = gridDim.x * gridDim.y * gridDim.z;
    unsigned sum, cnt, mine, sp = 0u;
    for (;;) {
        sum = 0u; cnt = 0u; mine = 0u;
#pragma unroll
        for (unsigned j = 0; j < 16; ++j) { const unsigned c = xb_ld(&bar[XB_XCNT(j)]); sum += c; cnt += (c > 0u) ? 1u : 0u; mine = (j == x) ? c : mine; }
        if (sum == Gn) break;
        __builtin_amdgcn_s_sleep(1);
        if ((++sp & 255u) == 0u) { if (xb_ld(&bar[XB_TMO])) break; if (sp > XB_SPIN_CAP) { atomicAdd(&bar[XB_TMO], 1u); break; } }
    }
    nloc = mine > 0u ? mine : 1u; nx = cnt > 0u ? cnt : 1u;
}
__device__ __forceinline__ void xcd_barrier(const XcdBarrier& b) {
    asm volatile("s_waitcnt vmcnt(0)" ::: "memory");
    __syncthreads();
    if (threadIdx.x == 0) {
        unsigned* bar = b.bar;
        __builtin_amdgcn_s_waitcnt(0);
        unsigned nloc = b.st[0], nx = b.st[1];
        if (nloc == 0u) { xcd_barrier_complete(bar, b.x, nloc, nx); b.st[0] = nloc; b.st[1] = nx; }
        const unsigned old = xb_add(&bar[XB_XSUB(b.x)], 1u);
        const unsigned gen = old / nloc;
        if (old + 1u == (gen + 1u) * nloc) {
            __builtin_amdgcn_fence(__ATOMIC_RELEASE, "agent");
            asm volatile("s_waitcnt vmcnt(0)" ::: "memory");
            const unsigned og = xb_add(&bar[XB_TOP], 1u);
            const unsigned tg = og / nx;
            if (og + 1u == (tg + 1u) * nx) xb_add(&bar[XB_TOPGEN], 1u);
            else XB_SPIN(xb_ld(&bar[XB_TOPGEN]) == tg, bar);
            __builtin_amdgcn_fence(__ATOMIC_ACQUIRE, "agent");
            xb_add(&bar[XB_XGEN(b.x)], 1u);
            asm volatile("s_waitcnt vmcnt(0)" ::: "memory");
        } else {
            XB_SPIN(xb_ld(&bar[XB_XGEN(b.x)]) == gen, bar);
            __builtin_amdgcn_fence(__ATOMIC_ACQUIRE, "agent");
            asm volatile("s_waitcnt vmcnt(0)" ::: "memory");
        }
    }
    __syncthreads();
}

struct Args { const float* in[23]; float* out; unsigned char* ws; unsigned long long pmask; };
struct Frame {
    LAS unsigned char* lds; int tid, lane, wave, G, bid;
    const float* in[23]; float* out; unsigned char* ws;
};

__device__ __forceinline__ void phase_mod(Frame& F) {
    const float* c = F.in[1]; const float* w_ada = F.in[2]; const float* b_ada = F.in[3]; float* mod = (float*)(F.ws + WS_MOD);
    LAS float* cs = (LAS float*)F.lds;
    LAS f32x4* part = (LAS f32x4*)(F.lds + 16384);
    for (int i = F.tid; i < NB * D; i += NTHR) cs[i] = silu_f(c[i]);
    __syncthreads();
    for (int blk = F.bid; blk < 2 * 6 * D / 48; blk += F.G) {
        const int gn0 = blk * 48, li = gn0 / (6 * D), n0 = gn0 % (6 * D);
        const int kq = F.lane / 12, cq = F.lane % 12; const bool act = F.lane < 60;
        const float* w = w_ada + (size_t)li * D * 6 * D + n0 + 4 * cq;
        f32x4 a0 = (f32x4){0.f, 0.f, 0.f, 0.f}, a1 = a0, a2 = a0, a3 = a0;
        if (act) {
#pragma unroll 13
            for (int i = 0; i < 26; ++i) { const int kl = kq + 5 * i; if (kl < 128) { const int k = 128 * F.wave + kl; const f32x4 wv = *(const GAS f32x4*)(w + (size_t)k * 6 * D);
                a0 += cs[k] * wv; a1 += cs[D + k] * wv; a2 += cs[2 * D + k] * wv; a3 += cs[3 * D + k] * wv; } }
            LAS f32x4* pp = part + ((F.wave * 5 + kq) * 12 + cq) * 4; pp[0] = a0; pp[1] = a1; pp[2] = a2; pp[3] = a3;
        }
        __syncthreads();
        if (F.tid < 48 * NB) { const int bq = F.tid / 48, col = F.tid % 48, cq2 = col >> 2, e = col & 3; float sum = 0.f;
            for (int i = 0; i < 40; ++i) sum += part[(i * 12 + cq2) * 4 + bq][e];
            mod[((size_t)li * NB + bq) * 6 * D + n0 + col] = sum + b_ada[li * 6 * D + n0 + col]; }
        __syncthreads();
    }
}
__device__ __forceinline__ void transpose_item(const float* W, int ldw, int src_col0, bf16_t* WT, int Kd, int dst_row0, int k0, float scale, LAS float* scr, int lane) {
    const int kr = lane >> 4, c4 = lane & 15;
#pragma unroll 8
    for (int i = 0; i < 16; ++i) { const int kk = 4 * i + kr; const f32x4 v = *(const GAS f32x4*)(W + (size_t)(k0 + kk) * ldw + src_col0 + 4 * c4) * scale;
        LAS float* d = scr + kk * 65 + 4 * c4; d[0] = v.x; d[1] = v.y; d[2] = v.z; d[3] = v.w; }
    LDS_WAIT(); asm volatile("" ::: "memory");
    const int c = lane & 7;
#pragma unroll
    for (int j = 0; j < 8; ++j) { const int n = (lane >> 3) + 8 * j; const LAS float* sp = scr + (8 * c) * 65 + n;
        u32x4 o; o.x = pk2(sp[0 * 65], sp[1 * 65]); o.y = pk2(sp[2 * 65], sp[3 * 65]); o.z = pk2(sp[4 * 65], sp[5 * 65]); o.w = pk2(sp[6 * 65], sp[7 * 65]);
        *(GAS u32x4*)(WT + (size_t)(dst_row0 + n) * Kd + k0 + 8 * c) = o; }
    LDS_WAIT(); asm volatile("" ::: "memory");
}
__device__ __forceinline__ void phase_convert(Frame& F) {
    LAS float* scr = (LAS float*)(F.lds + F.wave * 16640);
    const int gw = F.bid * NWAVES + F.wave, NGW = F.G * NWAVES;
    constexpr int I_GLU = (D / 64) * (2 * D / 64), I_IN = (D / 64) * (NQKVR / 64), I_OUT = (D / 64) * (D / 64), I_1 = (D / 64) * (DFF / 64), I_2 = (DFF / 64) * (D / 64);
    constexpr int NITEMS = I_GLU + I_IN + I_OUT + 2 * I_1 + 2 * I_2;
    bf16_t* WGLU = (bf16_t*)(F.ws + WS_WGLU); bf16_t* WIN = (bf16_t*)(F.ws + WS_WIN); bf16_t* WOUT = (bf16_t*)(F.ws + WS_WOUT);
    bf16_t* W1 = (bf16_t*)(F.ws + WS_W1); bf16_t* W2 = (bf16_t*)(F.ws + WS_W2);
    for (int it = gw; it < NITEMS; it += NGW) {
        int r = it;
        if (r < I_GLU) { const int nblk = 2 * D / 64, kb = r / nblk, nb = r % nblk, n0 = nb * 64;
            const int isg = n0 >= D, nn = isg ? n0 - D : n0, drow = 256 * (nn / 128) + 128 * isg + (nn % 128);
            transpose_item(F.in[14], 2 * D, n0, WGLU, D, drow, kb * 64, 1.f, scr, F.lane); continue; } r -= I_GLU;
        if (r < I_IN) { const int nblk = NQKVR / 64, kb = r / nblk, nb = r % nblk, n0 = nb * 64; const int src = n0 < 2048 ? n0 : n0 + RANK;
            transpose_item(F.in[15], GIN, src, WIN, D, n0, kb * 64, n0 < QKW ? 0.08838834764831845f : 1.f, scr, F.lane); continue; } r -= I_IN;
        if (r < I_OUT) { const int nblk = D / 64, kb = r / nblk, nb = r % nblk; transpose_item(F.in[19], D, nb * 64, WOUT, D, nb * 64, kb * 64, 1.f, scr, F.lane); continue; } r -= I_OUT;
        if (r < 2 * I_1) { const int l = r / I_1; r -= l * I_1; const int nblk = DFF / 64, kb = r / nblk, nb = r % nblk;
            transpose_item(F.in[20] + (size_t)l * D * DFF, DFF, nb * 64, W1 + (size_t)l * DFF * D, D, nb * 64, kb * 64, 1.f, scr, F.lane); continue; } r -= 2 * I_1;
        { const int l = r / I_2; r -= l * I_2; const int nblk = D / 64, kb = r / nblk, nb = r % nblk;
            transpose_item(F.in[21] + (size_t)l * DFF * D, D, nb * 64, W2 + (size_t)l * D * DFF, DFF, nb * 64, kb * 64, 1.f, scr, F.lane); }
    }
    __syncthreads();
}
__device__ __forceinline__ void phase_s5tables(Frame& F) {
    LAS float* LAMP = (LAS float*)F.lds;
    LAS float* BB = LAMP + 17 * 64 * 2;
    LAS float* CC = BB + 64 * 16 * 2;
    LAS float* KK = CC + 16 * 64 * 2;
    const float* a_re = F.in[6]; const float* a_im = F.in[7]; const float* log_dt = F.in[8]; const float* b_re = F.in[9]; const float* b_im = F.in[10];
    const float* c_re = F.in[11]; const float* c_im = F.in[12]; const float* dsk = F.in[13];
    bf16_t* TT = (bf16_t*)(F.ws + WS_TT); bf16_t* WST = (bf16_t*)(F.ws + WS_WST);
    for (int job = F.bid; job < 4 * G; job += F.G) { const int g = job >> 2, qt = job & 3;
        __syncthreads();
        const double dt = exp((double)log_dt[g]);
        for (int idx = F.tid; idx < 17 * 64; idx += NTHR) { const int m = idx >> 6, p = idx & 63; const double ar = a_re[g * P + p], ai = a_im[g * P + p];
            const double mag = exp(ar * dt * m), ph = ai * dt * m; LAMP[idx * 2] = (float)(mag * cos(ph)); LAMP[idx * 2 + 1] = (float)(mag * sin(ph)); }
        for (int idx = F.tid; idx < 64 * 16; idx += NTHR) { const int p = idx >> 4, hh = idx & 15; const double ar = a_re[g * P + p], ai = a_im[g * P + p];
            const double mag = exp(ar * dt), ph = ai * dt, lr = mag * cos(ph), li = mag * sin(ph), den = ar * ar + ai * ai, nr = lr - 1.0, ni = li;
            const double fr = (nr * ar + ni * ai) / den, fi = (ni * ar - nr * ai) / den; const double br = b_re[(g * P + p) * HG + hh], bi = b_im[(g * P + p) * HG + hh];
            BB[idx * 2] = (float)(fr * br - fi * bi); BB[idx * 2 + 1] = (float)(fr * bi + fi * br); }
        for (int idx = F.tid; idx < 16 * 64; idx += NTHR) { CC[idx * 2] = c_re[g * HG * P + idx]; CC[idx * 2 + 1] = c_im[g * HG * P + idx]; }
        __syncthreads();
        for (int idx = F.tid; idx < 16 * 16 * 16; idx += NTHR) { const int m = idx >> 8, hh = (idx >> 4) & 15, h2 = idx & 15; float s = 0.f;
            for (int p = 0; p < P; ++p) { const float cr = CC[(hh * 64 + p) * 2], ci = CC[(hh * 64 + p) * 2 + 1], lr = LAMP[(m * 64 + p) * 2], li = LAMP[(m * 64 + p) * 2 + 1];
                const float clr = cr * lr - ci * li, cli = cr * li + ci * lr; s += clr * BB[(p * 16 + h2) * 2] - cli * BB[(p * 16 + h2) * 2 + 1]; }
            KK[idx] = s; }
        __syncthreads();
        for (int pc = F.tid; pc < 64 * 48; pc += NTHR) { const int row = 64 * qt + pc / 48, q = pc % 48, j = row >> 4, hh = row & 15; float v[8];
            if (q < 32) { const int s = q >> 1, h0 = (q & 1) * 8;
#pragma unroll
                for (int e = 0; e < 8; ++e) { float x = (j >= s) ? KK[((j - s) * 16 + hh) * 16 + h0 + e] : 0.f; if (s == j && hh == h0 + e) x += dsk[g * HG + hh]; v[e] = x; } }
            else {
#pragma unroll
                for (int e = 0; e < 8; ++e) { const int pcol = (q - 32) * 8 + e, p = pcol & 63; const float cr = CC[(hh * 64 + p) * 2], ci = CC[(hh * 64 + p) * 2 + 1], lr = LAMP[((j + 1) * 64 + p) * 2], li = LAMP[((j + 1) * 64 + p) * 2 + 1];
                    v[e] = pcol < 64 ? (cr * lr - ci * li) : -(cr * li + ci * lr); } }
            u32x4 o; o.x = pk2(v[0], v[1]); o.y = pk2(v[2], v[3]); o.z = pk2(v[4], v[5]); o.w = pk2(v[6], v[7]);
            *(GAS u32x4*)(TT + ((size_t)g * 256 + row) * UA + q * 8) = o; }
        for (int pc = F.tid; pc < 32 * 32; pc += NTHR) { const int row = 32 * qt + (pc >> 5), q = pc & 31, p = row & 63, s = q >> 1, h0 = (q & 1) * 8; float v[8];
            const float lr = LAMP[((15 - s) * 64 + p) * 2], li = LAMP[((15 - s) * 64 + p) * 2 + 1];
#pragma unroll
            for (int e = 0; e < 8; ++e) { const float br = BB[(p * 16 + h0 + e) * 2], bi = BB[(p * 16 + h0 + e) * 2 + 1]; v[e] = row < 64 ? (lr * br - li * bi) : (lr * bi + li * br); }
            u32x4 o; o.x = pk2(v[0], v[1]); o.y = pk2(v[2], v[3]); o.z = pk2(v[4], v[5]); o.w = pk2(v[6], v[7]);
            *(GAS u32x4*)(WST + ((size_t)g * 128 + row) * UK + q * 8) = o; }
    }
    __syncthreads();
}

__device__ __forceinline__ void normmod_row(const float* xrow, const float* nw, const float* sh, const float* sc, int lane, f32x4 (&v)[4]) {
    const GAS f32x4* xr = (const GAS f32x4*)xrow + lane; float s = 0.f;
#pragma unroll
    for (int j = 0; j < 4; ++j) { v[j] = xr[64 * j]; s += (v[j].x * v[j].x + v[j].y * v[j].y) + (v[j].z * v[j].z + v[j].w * v[j].w); }
    const float rstd = 1.0f / sqrtf(wave_sum(s) * (1.f / D) + EPS);
#pragma unroll
    for (int j = 0; j < 4; ++j) { const f32x4 w = ((const GAS f32x4*)nw)[lane + 64 * j]; v[j] = v[j] * rstd * w;
        if (sc) { const f32x4 a = ((const GAS f32x4*)sc)[lane + 64 * j], b = ((const GAS f32x4*)sh)[lane + 64 * j]; v[j] = v[j] * (1.f + a) + b; } }
}
__device__ __forceinline__ void phase_upass(Frame& F) {
    const float* x = F.in[0]; const float* nw = F.in[4]; const float* mod = (const float*)(F.ws + WS_MOD); bf16_t* UAUG = (bf16_t*)(F.ws + WS_UAUG);
    const int gw = F.bid * NWAVES + F.wave, NGW = F.G * NWAVES;
    for (int m = gw; m < T; m += NGW) {
        const int b = m / SEQ, tt = m % SEQ, c = tt / QC, s = tt % QC; const float* mb = mod + (size_t)b * 6 * D;
        f32x4 v[4]; normmod_row(x + (size_t)m * D, nw, mb, mb + D, F.lane, v);
#pragma unroll
        for (int j = 0; j < 4; ++j) { const int g = (F.lane >> 2) + 16 * j, h0 = 4 * (F.lane & 3);
            u32x2 o; o.x = pk2(v[j].x, v[j].y); o.y = pk2(v[j].z, v[j].w);
            *(GAS u32x2*)(UAUG + ((size_t)g * BC + b * NCH + c) * UA + s * 16 + h0) = o; }
    }
}
template <bool WITH_GLR>
__device__ __forceinline__ void phase_normmod(Frame& F, const float* nw, const float* mod_l  , int sh_idx) {
    const float* X = F.out; bf16_t* H = (bf16_t*)(F.ws + WS_H); float* GLR = (float*)(F.ws + WS_GLR); const float* w_in = F.in[15];
    const int gw = F.bid * NWAVES + F.wave, NGW = F.G * NWAVES;
    LAS float* wg = (LAS float*)F.lds;
    if constexpr (WITH_GLR) {
        for (int i = F.tid; i < D * RANK; i += NTHR) { const int k = i >> 4, r = i & 15; wg[r * D + k] = w_in[(size_t)k * GIN + 2048 + r]; }
        __syncthreads();
    }
    for (int m = gw; m < T; m += NGW) {
        const int b = m / SEQ; const float* mb = mod_l + (size_t)b * 6 * D + (size_t)sh_idx * D;
        f32x4 v[4]; normmod_row(X + (size_t)m * D, nw, mb, mb + D, F.lane, v);
        GAS u32x2* o8 = (GAS u32x2*)(H + (size_t)m * D) + F.lane;
#pragma unroll
        for (int j = 0; j < 4; ++j) { u32x2 o; o.x = pk2(v[j].x, v[j].y); o.y = pk2(v[j].z, v[j].w); o8[64 * j] = o; }
        if constexpr (WITH_GLR) {
            float myv = 0.f;
#pragma unroll 2
            for (int r = 0; r < RANK; ++r) { float s = 0.f;
#pragma unroll
                for (int j = 0; j < 4; ++j) { const f32x4 w = *(const LAS f32x4*)(wg + r * D + 4 * F.lane + 256 * j); s += (v[j].x * w.x + v[j].y * w.y) + (v[j].z * w.z + v[j].w * w.w); }
                s = wave_sum(s); if (F.lane == r) myv = s; }
            if (F.lane < RANK) GLR[(size_t)m * RANK + F.lane] = myv;
        }
    }
    if constexpr (WITH_GLR) __syncthreads();
}
__device__ __forceinline__ void phase_final(Frame& F) {
    float* X = F.out; const float* nw = F.in[22];
    const int gw = F.bid * NWAVES + F.wave, NGW = F.G * NWAVES;
    for (int m = gw; m < T; m += NGW) {
        f32x4 v[4]; normmod_row(X + (size_t)m * D, nw, nullptr, nullptr, F.lane, v);
        GAS f32x4* o = (GAS f32x4*)(X + (size_t)m * D) + F.lane;
#pragma unroll
        for (int j = 0; j < 4; ++j) o[64 * j] = v[j];
    }
}
__device__ __forceinline__ void phase_scan(Frame& F) {
    const float* a_re = F.in[6]; const float* a_im = F.in[7]; const float* log_dt = F.in[8];
    const float* SLOC = (const float*)(F.ws + WS_SLOC); bf16_t* UAUG = (bf16_t*)(F.ws + WS_UAUG);
    LAS float* ends = (LAS float*)F.lds;
    const int p = F.lane, w = F.wave; constexpr int SEG = NCH / NWAVES;
    for (int task = F.bid; task < G * NB; task += F.G) {
        const int g = task >> 2, b = task & 3;
        const double dt = exp((double)log_dt[g]), ar = a_re[g * P + p], ai = a_im[g * P + p];
        const double mag = exp(ar * dt * QC), ph = ai * dt * QC, magS = exp(ar * dt * QC * SEG), phS = ai * dt * QC * SEG;
        const float lr = (float)(mag * cos(ph)), li = (float)(mag * sin(ph)), sr_ = (float)(magS * cos(phS)), si_ = (float)(magS * sin(phS));
        const float* sl = SLOC + ((size_t)g * BC + b * NCH + w * SEG) * 128 + p; bf16_t* ua = UAUG + ((size_t)g * BC + b * NCH + w * SEG) * UA + UK + p;
        float lre[SEG], lim[SEG], sre[SEG], sim[SEG];
#pragma unroll
        for (int c = 0; c < SEG; ++c) { sre[c] = sl[(size_t)c * 128]; sim[c] = sl[(size_t)c * 128 + 64]; }
        float xr = 0.f, xi = 0.f;
#pragma unroll
        for (int c = 0; c < SEG; ++c) { lre[c] = xr; lim[c] = xi; const float nr = lr * xr - li * xi + sre[c], ni = lr * xi + li * xr + sim[c]; xr = nr; xi = ni; }
        __syncthreads();
        ends[(w * 64 + p) * 2] = xr; ends[(w * 64 + p) * 2 + 1] = xi;
        __syncthreads();
        float br = 0.f, bi = 0.f;
        for (int v = 0; v < w; ++v) { const float er = ends[(v * 64 + p) * 2], ei = ends[(v * 64 + p) * 2 + 1]; const float nr = sr_ * br - si_ * bi + er, ni = sr_ * bi + si_ * br + ei; br = nr; bi = ni; }
#pragma unroll
        for (int c = 0; c < SEG; ++c) { const float orr = lre[c] + br, oi = lim[c] + bi;
            ua[(size_t)c * UA] = (bf16_t)f2bf(orr); ua[(size_t)c * UA + 64] = (bf16_t)f2bf(oi);
            const float nr = lr * br - li * bi, ni = lr * bi + li * br; br = nr; bi = ni; }
    }
    __syncthreads();
}

struct ProbBase { pg8::StaticOrder S; __device__ __forceinline__ bool next(int i, Unit& u) const { return S.next(i, u); } };
struct ProbGrouped { int c; __device__ __forceinline__ bool next(int i, Unit& u) const { if (i > 0) return false; u.pm = c & 3; u.pn = c >> 2; return true; } };
struct ProbSloc : ProbGrouped {
    static constexpr bool PERM = false; int K, ldb; size_t a_kstep, a_hstep; const bf16_t* UAUG; const bf16_t* WST; float* SLOC;
    __device__ __forceinline__ unsigned a_voff(int R, int C) const { return (unsigned)(R * UA + C) * 2u; }
    __device__ __forceinline__ const char* a_base(const Unit& u) const { return (const char*)(UAUG + ((size_t)u.pn * BC + u.pm * 256) * UA); }
    __device__ __forceinline__ const char* b_base(const Unit& u) const { return (const char*)(WST + (size_t)u.pn * 128 * UK); }
    __device__ __forceinline__ void epi(const AccT& acc, const Unit& u, int wr, int wc, int fr, int fq) const {
#pragma unroll
        for (int ai = 0; ai < 2; ++ai)
#pragma unroll
            for (int m = 0; m < 4; ++m) { const int row = u.pm * 256 + ai * 128 + wr * 64 + m * 16 + fr; float* rp = SLOC + ((size_t)u.pn * BC + row) * 128 + wc * 32 + 4 * fq;
#pragma unroll
                for (int n = 0; n < 2; ++n) *(f32x4*)(rp + n * 16) = acc[ai][0][m][n]; }
    }
};
struct ProbY : ProbGrouped {
    static constexpr bool PERM = true; int K, ldb; size_t a_kstep, a_hstep; const bf16_t* UAUG; const bf16_t* TT; bf16_t* ZT;
    __device__ __forceinline__ unsigned a_voff(int R, int C) const { return (unsigned)(R * UA + C) * 2u; }
    __device__ __forceinline__ const char* a_base(const Unit& u) const { return (const char*)(UAUG + ((size_t)u.pn * BC + u.pm * 256) * UA); }
    __device__ __forceinline__ const char* b_base(const Unit& u) const { return (const char*)(TT + (size_t)u.pn * 256 * UA); }
    __device__ __forceinline__ void epi(const AccT& acc, const Unit& u, int wr, int wc, int fr, int fq) const {
#pragma unroll
        for (int ai = 0; ai < 2; ++ai)
#pragma unroll
            for (int m = 0; m < 4; ++m) { const int row = u.pm * 256 + ai * 128 + wr * 64 + m * 16 + fr; bf16_t* rp = ZT + (size_t)u.pn * T * 16 + (size_t)row * 256 + wc * 32 + 8 * fq;
#pragma unroll
                for (int bj = 0; bj < 2; ++bj) { const f32x4 v0 = acc[ai][bj][m][0], v1 = acc[ai][bj][m][1]; u32x4 w;
                    w.x = cvt_pk_bf16(fast_gelu_tanh(v0[0]), fast_gelu_tanh(v0[1])); w.y = cvt_pk_bf16(fast_gelu_tanh(v0[2]), fast_gelu_tanh(v0[3]));
                    w.z = cvt_pk_bf16(fast_gelu_tanh(v1[0]), fast_gelu_tanh(v1[1])); w.w = cvt_pk_bf16(fast_gelu_tanh(v1[2]), fast_gelu_tanh(v1[3]));
                    *(u32x4*)(rp + bj * 128) = w; } }
    }
};
struct ProbGLU : ProbBase {
    static constexpr bool PERM = false; int K, ldb; size_t a_kstep, a_hstep; const bf16_t* ZT; const bf16_t* W; const float* xin; float* X; const float* gt  ;
    __device__ __forceinline__ unsigned a_voff(int R, int C) const { return (unsigned)((C >> 4) * T * 32 + R * 32 + (C & 15) * 2); }
    __device__ __forceinline__ const char* a_base(const Unit& u) const { return (const char*)ZT + (size_t)u.pm * 256 * 32; }
    __device__ __forceinline__ const char* b_base(const Unit& u) const { return (const char*)(W + (size_t)u.pn * 256 * D); }
    __device__ __forceinline__ void epi(const AccT& acc, const Unit& u, int wr, int wc, int fr, int fq) const {
        const int b = u.pm >> 4, col0 = u.pn * 128 + wc * 32 + 4 * fq; f32x4 gv[2];
#pragma unroll
        for (int n = 0; n < 2; ++n) gv[n] = *(const f32x4*)(gt + (size_t)b * 6 * D + col0 + n * 16);
#pragma unroll
        for (int ai = 0; ai < 2; ++ai)
#pragma unroll
            for (int m = 0; m < 4; ++m) { const size_t off = (size_t)(u.pm * 256 + ai * 128 + wr * 64 + m * 16 + fr) * D + col0;
#pragma unroll
                for (int n = 0; n < 2; ++n) { const f32x4 val = acc[ai][0][m][n], gate = acc[ai][1][m][n]; const f32x4 xv = *(const f32x4*)(xin + off + n * 16); f32x4 o;
                    o[0] = xv[0] + gv[n][0] * val[0] * fast_sigmoid(gate[0]); o[1] = xv[1] + gv[n][1] * val[1] * fast_sigmoid(gate[1]);
                    o[2] = xv[2] + gv[n][2] * val[2] * fast_sigmoid(gate[2]); o[3] = xv[3] + gv[n][3] * val[3] * fast_sigmoid(gate[3]);
                    *(f32x4*)(X + off + n * 16) = o; } }
    }
};
struct ProbPlain : ProbBase {
    int K, ldb, lda; size_t a_kstep, a_hstep; const bf16_t* A; const bf16_t* W;
    __device__ __forceinline__ unsigned a_voff(int R, int C) const { return (unsigned)(R * lda + C) * 2u; }
    __device__ __forceinline__ const char* a_base(const Unit& u) const { return (const char*)(A + (size_t)u.pm * 256 * lda); }
    __device__ __forceinline__ const char* b_base(const Unit& u) const { return (const char*)(W + (size_t)u.pn * 256 * ldb); }
};
template <int ACT  > struct ProbBf16Out : ProbPlain {
    static constexpr bool PERM = true; bf16_t* O; int ldc;
    __device__ __forceinline__ void epi(const AccT& acc, const Unit& u, int wr, int wc, int fr, int fq) const {
#pragma unroll
        for (int ai = 0; ai < 2; ++ai)
#pragma unroll
            for (int m = 0; m < 4; ++m) { bf16_t* rp = O + (size_t)(u.pm * 256 + ai * 128 + wr * 64 + m * 16 + fr) * ldc + u.pn * 256 + wc * 32 + 8 * fq;
#pragma unroll
                for (int bj = 0; bj < 2; ++bj) { f32x4 v0 = acc[ai][bj][m][0], v1 = acc[ai][bj][m][1];
                    if (ACT == 1) { v0 = __builtin_elementwise_max(v0, (f32x4){0.f, 0.f, 0.f, 0.f}); v1 = __builtin_elementwise_max(v1, (f32x4){0.f, 0.f, 0.f, 0.f}); v0 = v0 * v0; v1 = v1 * v1; }
                    u32x4 w; w.x = cvt_pk_bf16(v0[0], v0[1]); w.y = cvt_pk_bf16(v0[2], v0[3]); w.z = cvt_pk_bf16(v1[0], v1[1]); w.w = cvt_pk_bf16(v1[2], v1[3]);
                    *(u32x4*)(rp + bj * 128) = w; } }
    }
};
struct ProbResid : ProbPlain {
    static constexpr bool PERM = false; float* X; const float* gt;
    __device__ __forceinline__ void epi(const AccT& acc, const Unit& u, int wr, int wc, int fr, int fq) const {
        const int b = u.pm >> 4, col0 = u.pn * 256 + wc * 32 + 4 * fq; f32x4 gv[2][2];
#pragma unroll
        for (int bj = 0; bj < 2; ++bj)
#pragma unroll
            for (int n = 0; n < 2; ++n) gv[bj][n] = *(const f32x4*)(gt + (size_t)b * 6 * D + col0 + bj * 128 + n * 16);
#pragma unroll
        for (int ai = 0; ai < 2; ++ai)
#pragma unroll
            for (int m = 0; m < 4; ++m) { const size_t off = (size_t)(u.pm * 256 + ai * 128 + wr * 64 + m * 16 + fr) * D + col0;
#pragma unroll
                for (int bj = 0; bj < 2; ++bj)
#pragma unroll
                    for (int n = 0; n < 2; ++n) { float* p = X + off + bj * 128 + n * 16; const f32x4 xv = *(const f32x4*)p; *(f32x4*)p = xv + gv[bj][n] * acc[ai][bj][m][n]; }
                if (m & 1) asm volatile("" ::: "memory"); }
    }
};

__device__ __forceinline__ float fast_logsigmoid(float a) {
    const float e = __builtin_amdgcn_exp2f(-1.4426950408889634f * __builtin_fabsf(a));
    return fminf(a, 0.f) - 0.6931471805599453f * __builtin_amdgcn_logf(1.f + e);
}
__device__ __forceinline__ int img_off(int row, int ch) { return 256 * row + 16 * (ch ^ (((row & 3) << 2) | ((row >> 2) & 3))); }
typedef short v4i16_t __attribute__((ext_vector_type(4)));
__device__ __forceinline__ v4i16_t lds_tr16(const LAS unsigned char* p) { return __builtin_amdgcn_ds_read_tr16_b64_v4i16((LAS v4i16_t*)p); }
__device__ __forceinline__ float sum_groups16(float x) {
    const unsigned u = __builtin_bit_cast(unsigned, x);
    auto r = __builtin_amdgcn_permlane16_swap(u, u, false, false);
    const float y = __builtin_bit_cast(float, (unsigned)r[0]) + __builtin_bit_cast(float, (unsigned)r[1]);
    const unsigned v = __builtin_bit_cast(unsigned, y);
    auto q = __builtin_amdgcn_permlane32_swap(v, v, false, false);
    return __builtin_bit_cast(float, (unsigned)q[0]) + __builtin_bit_cast(float, (unsigned)q[1]);
}
__device__ __forceinline__ void phase_gla_kdec(Frame& F) {
    const bf16_t* QKVR = (const bf16_t*)(F.ws + WS_QKVR); const float* GLR = (const float*)(F.ws + WS_GLR); const float* w2 = F.in[16]; const float* bg = F.in[17];
    bf16_t* KVF = (bf16_t*)(F.ws + WS_KVF); float* DEC = (float*)(F.ws + WS_DEC);
    LAS float* glr = (LAS float*)F.lds;
    constexpr int KP = QKW + 8, VP = DV + 8;
    LAS bf16_t* kt = (LAS bf16_t*)(F.lds + 4096);
    LAS bf16_t* vt = kt + 64 * KP;
    const int j = F.tid, lane = F.lane, w = F.wave, g = lane >> 4, li = lane & 15, q4 = li >> 2, p4 = li & 3;
    float w2c[RANK];
#pragma unroll
    for (int r = 0; r < RANK; ++r) w2c[r] = w2[r * QKW + j];
    const float bgc = bg[j];
    for (int unit = F.bid; unit < NB * (SEQ / CH); unit += F.G) {
        const size_t m0 = (size_t)unit * CH;
        __syncthreads();
        for (int i = F.tid; i < CH * RANK; i += NTHR) glr[i] = GLR[m0 * RANK + i];
#pragma unroll
        for (int i = 0; i < 8; ++i) { const int idx = F.tid + NTHR * i, row = idx >> 6, ch = idx & 63;
            *(LAS u32x4*)(kt + row * KP + ch * 8) = *(const GAS u32x4*)(QKVR + (m0 + row) * NQKVR + QKW + ch * 8); }
        u32x4 rv[4];
#pragma unroll
        for (int i = 0; i < 4; ++i) { const int idx = F.tid + NTHR * i, row = idx >> 5, ch = idx & 31; rv[i] = *(const GAS u32x4*)(QKVR + (m0 + row) * NQKVR + 2 * QKW + ch * 8); }
        __syncthreads();
        { float gc[CH]; float run = 0.f;
#pragma unroll
            for (int s = 0; s < CH; ++s) { float a = bgc;
#pragma unroll
                for (int r4 = 0; r4 < 4; ++r4) { const f32x4 gv = *(const LAS f32x4*)(glr + s * 16 + r4 * 4); a += (gv.x * w2c[4 * r4] + gv.y * w2c[4 * r4 + 1]) + (gv.z * w2c[4 * r4 + 2] + gv.w * w2c[4 * r4 + 3]); }
                run += fast_logsigmoid(a) * (1.f / 16.f); gc[s] = run; }
#pragma unroll
            for (int s = 0; s < CH; ++s) { const float kv = bf2f(kt[s * KP + j]);
                kt[s * KP + j] = (bf16_t)f2bf(kv * __builtin_amdgcn_exp2f(1.4426950408889634f * (run - gc[s]))); }
            DEC[(size_t)unit * QKW + j] = __builtin_amdgcn_exp2f(1.4426950408889634f * run); }
#pragma unroll 1
        for (int hh = 0; hh < NH; ++hh) {
            __syncthreads();
#pragma unroll
            for (int i = 0; i < 4; ++i) { const int idx = F.tid + NTHR * i, row = idx >> 5, ch = idx & 31; *(LAS u32x4*)(vt + row * VP + ch * 8) = rv[i]; }
            if (hh + 1 < NH) {
#pragma unroll
                for (int i = 0; i < 4; ++i) { const int idx = F.tid + NTHR * i, row = idx >> 5, ch = idx & 31; rv[i] = *(const GAS u32x4*)(QKVR + (m0 + row) * NQKVR + 2 * QKW + (hh + 1) * DV + ch * 8); } }
            __syncthreads();
            f32x4 acc[2][8];
#pragma unroll
            for (int e = 0; e < 2; ++e)
#pragma unroll
                for (int dt = 0; dt < 8; ++dt) acc[e][dt] = (f32x4){0.f, 0.f, 0.f, 0.f};
#pragma unroll
            for (int ks = 0; ks < 2; ++ks) { const int r0 = 32 * ks + 8 * g + q4; bf16x8 vf[2];
#pragma unroll
                for (int e = 0; e < 2; ++e) { const v4i16_t lo = lds_tr16((const LAS unsigned char*)(vt + r0 * VP + 16 * (2 * w + e) + 4 * p4)), hi = lds_tr16((const LAS unsigned char*)(vt + (r0 + 4) * VP + 16 * (2 * w + e) + 4 * p4));
                    vf[e] = (bf16x8){lo[0], lo[1], lo[2], lo[3], hi[0], hi[1], hi[2], hi[3]}; }
#pragma unroll
                for (int dt = 0; dt < 8; ++dt) { const v4i16_t lo = lds_tr16((const LAS unsigned char*)(kt + r0 * KP + hh * DK + 16 * dt + 4 * p4)), hi = lds_tr16((const LAS unsigned char*)(kt + (r0 + 4) * KP + hh * DK + 16 * dt + 4 * p4));
                    const bf16x8 kf = (bf16x8){lo[0], lo[1], lo[2], lo[3], hi[0], hi[1], hi[2], hi[3]};
#pragma unroll
                    for (int e = 0; e < 2; ++e) acc[e][dt] = __builtin_amdgcn_mfma_f32_16x16x32_bf16(kf, vf[e], acc[e][dt], 0, 0, 0); } }
            bf16_t* kvo = KVF + ((size_t)(unit * NH + hh) * 16 + 2 * w) * 8 * 256 + lane * 4;
#pragma unroll
            for (int e = 0; e < 2; ++e)
#pragma unroll
                for (int dt = 0; dt < 8; ++dt) { u32x2 o; o.x = cvt_pk_bf16(acc[e][dt][0], acc[e][dt][1]); o.y = cvt_pk_bf16(acc[e][dt][2], acc[e][dt][3]); *(GAS u32x2*)(kvo + (e * 8 + dt) * 256) = o; }
        }
    }
    __syncthreads();
}
__device__ __forceinline__ void phase_gla_escan(Frame& F) {
    bf16_t* KVF = (bf16_t*)(F.ws + WS_KVF); const float* DEC = (const float*)(F.ws + WS_DEC);
    constexpr int NCK = SEQ / CH, SLAB = NH * 16 * 8;
    for (int fid = F.bid * NTHR + F.tid; fid < NB * SLAB * 64; fid += F.G * NTHR) {
        const int lane = fid & 63, tile = fid >> 6, ts = tile & (SLAB - 1), b = tile / SLAB, dt = ts & 7, hh = ts >> 7, g = lane >> 4;
        bf16_t* kp = KVF + ((size_t)(b * NCK) * SLAB + ts) * 256 + lane * 4; const float* dp = DEC + (size_t)(b * NCK) * QKW + hh * DK + 16 * dt + 4 * g;
        f32x4 S = (f32x4){0.f, 0.f, 0.f, 0.f};
#pragma unroll 8
        for (int n = 0; n < NCK; ++n) {
            const u32x2 kv = *(const GAS u32x2*)(kp + (size_t)n * SLAB * 256); const f32x4 dc = *(const GAS f32x4*)(dp + (size_t)n * QKW);
            const f32x4 kvv = (f32x4){__builtin_bit_cast(float, kv.x << 16), __builtin_bit_cast(float, kv.x & 0xffff0000u), __builtin_bit_cast(float, kv.y << 16), __builtin_bit_cast(float, kv.y & 0xffff0000u)};
            S = S * dc + kvv;
            u32x2 o; o.x = cvt_pk_bf16(S[0], S[1]); o.y = cvt_pk_bf16(S[2], S[3]); *(GAS u32x2*)(kp + (size_t)n * SLAB * 256) = o;
        }
    }
}
__device__ __forceinline__ void phase_gla_out(Frame& F) {
    bf16_t* QKVR = (bf16_t*)(F.ws + WS_QKVR); const bf16_t* KVF = (const bf16_t*)(F.ws + WS_KVF); const float* gn = F.in[18];
    const int tid = F.tid, lane = F.lane, w = F.wave, g = lane >> 4, li = lane & 15;
    LAS unsigned char* Bq = F.lds;
    LAS float* red = (LAS float*)(F.lds + 16384);
    constexpr int SLAB = NH * 16 * 8;
    for (int unit = F.bid; unit < NB * (SEQ / CH) * NH; unit += F.G) {
        const int hh = unit & 3, bn = unit >> 2; const size_t m0 = (size_t)bn * CH;
        u32x2 sfr[2][8];
#pragma unroll
        for (int e = 0; e < 2; ++e)
#pragma unroll
            for (int dt = 0; dt < 8; ++dt) sfr[e][dt] = *(const GAS u32x2*)(KVF + ((size_t)bn * SLAB + (hh * 16 + 2 * w + e) * 8 + dt) * 256 + lane * 4);
        u32x2 rr[2][4]; f32x4 gv[2];
#pragma unroll
        for (int e = 0; e < 2; ++e) { gv[e] = *(const GAS f32x4*)(gn + hh * DV + 16 * (2 * w + e) + 4 * g);
#pragma unroll
            for (int cb = 0; cb < 4; ++cb) rr[e][cb] = *(const GAS u32x2*)(QKVR + (m0 + 16 * cb + li) * NQKVR + 2048 + hh * DV + 16 * (2 * w + e) + 4 * g); }
        __syncthreads();
#pragma unroll
        for (int i = 0; i < 2; ++i) { const int idx = tid + NTHR * i, row = idx >> 4, ch = idx & 15; *(LAS u32x4*)(Bq + img_off(row, ch)) = *(const GAS u32x4*)(QKVR + (m0 + row) * NQKVR + hh * DK + ch * 8); }
        __syncthreads();
        f32x4 acc[2][4]; float ssl[4];
#pragma unroll
        for (int cb = 0; cb < 4; ++cb) { const int c = 16 * cb + li; bf16x8 qf[4];
#pragma unroll
            for (int kk = 0; kk < 4; ++kk) { const u32x2 qlo = *(const LAS u32x2*)(Bq + img_off(c, 4 * kk + (g >> 1)) + 8 * (g & 1)), qhi = *(const LAS u32x2*)(Bq + img_off(c, 4 * kk + 2 + (g >> 1)) + 8 * (g & 1));
                u32x4 t; t.x = qlo.x; t.y = qlo.y; t.z = qhi.x; t.w = qhi.y; qf[kk] = __builtin_bit_cast(bf16x8, t); }
            float ss = 0.f;
#pragma unroll
            for (int e = 0; e < 2; ++e) { f32x4 a = (f32x4){0.f, 0.f, 0.f, 0.f};
#pragma unroll
                for (int kk = 0; kk < 4; ++kk) { u32x4 t; t.x = sfr[e][2 * kk].x; t.y = sfr[e][2 * kk].y; t.z = sfr[e][2 * kk + 1].x; t.w = sfr[e][2 * kk + 1].y;
                    a = __builtin_amdgcn_mfma_f32_16x16x32_bf16(__builtin_bit_cast(bf16x8, t), qf[kk], a, 0, 0, 0); }
                acc[e][cb] = a; ss += (a[0] * a[0] + a[1] * a[1]) + (a[2] * a[2] + a[3] * a[3]); }
            ssl[cb] = sum_groups16(ss); }
        if (g == 0) {
#pragma unroll
            for (int cb = 0; cb < 4; ++cb) red[w * 64 + 16 * cb + li] = ssl[cb]; }
        __syncthreads();
#pragma unroll
        for (int cb = 0; cb < 4; ++cb) { const int c = 16 * cb + li; float tot = 0.f;
#pragma unroll
            for (int v = 0; v < 8; ++v) tot += red[v * 64 + c];
            const float rstd = 1.0f / sqrtf(tot * (1.f / DV) + EPS);
#pragma unroll
            for (int e = 0; e < 2; ++e) { const u32x2 rv = rr[e][cb]; const float r0 = bf2f(rv.x & 0xffff), r1 = bf2f(rv.x >> 16), r2 = bf2f(rv.y & 0xffff), r3 = bf2f(rv.y >> 16); const f32x4 a = acc[e][cb];
                u32x2 o; o.x = cvt_pk_bf16(a[0] * rstd * gv[e][0] * r0 * fast_sigmoid(r0), a[1] * rstd * gv[e][1] * r1 * fast_sigmoid(r1));
                o.y = cvt_pk_bf16(a[2] * rstd * gv[e][2] * r2 * fast_sigmoid(r2), a[3] * rstd * gv[e][3] * r3 * fast_sigmoid(r3));
                *(GAS u32x2*)(QKVR + (m0 + c) * NQKVR + QKW + hh * DV + 16 * (2 * w + e) + 4 * g) = o; } }
    }
    __syncthreads();
}

template <int PHX> __device__ __forceinline__ void run_phase(Frame& F) {
    constexpr int PH = PHX & 63;
    const float* MOD = (const float*)(F.ws + WS_MOD);
    const bf16_t* UAUG = (const bf16_t*)(F.ws + WS_UAUG);
    LAS unsigned char* ring = F.lds;
    float* Xp = (PHX & 64) ? (float*)(F.ws + (PH == 14 ? 64 * MiB : 192 * MiB)) : F.out;

    if constexpr (PH == 0) { phase_s5tables(F); phase_mod(F); }
    if constexpr (PH == 1) { phase_upass(F); phase_convert(F); }
    if constexpr (PH == 2) { ProbSloc Pb; Pb.c = F.bid; Pb.K = UK; Pb.ldb = UK; Pb.a_kstep = 128; Pb.a_hstep = (size_t)128 * UA * 2; Pb.UAUG = UAUG; Pb.WST = (const bf16_t*)(F.ws + WS_WST); Pb.SLOC = (float*)(F.ws + WS_SLOC);
            pg8::gemm_phase<ProbSloc, true, true>(ring, Pb); }
    if constexpr (PH == 3) { phase_scan(F); }
    if constexpr (PH == 4) { ProbY Pb; Pb.c = F.bid; Pb.K = UA; Pb.ldb = UA; Pb.a_kstep = 128; Pb.a_hstep = (size_t)128 * UA * 2; Pb.UAUG = UAUG; Pb.TT = (const bf16_t*)(F.ws + WS_TT); Pb.ZT = (bf16_t*)(F.ws + WS_ZT);
            pg8::gemm_phase<ProbY, true, true>(ring, Pb); }
    if constexpr (PH == 5) { ProbGLU Pb; Pb.S.init(T, 2 * D, F.G, F.bid); Pb.K = D; Pb.ldb = D; Pb.a_kstep = (size_t)4 * T * 32; Pb.a_hstep = 128 * 32; Pb.ZT = (const bf16_t*)(F.ws + WS_ZT); Pb.W = (const bf16_t*)(F.ws + WS_WGLU);
            Pb.xin = F.in[0]; Pb.X = Xp; Pb.gt = MOD + 2 * D;
            pg8::gemm_phase<ProbGLU, true, true>(ring, Pb); }
    if constexpr (PH == 6) { phase_normmod<false>(F, F.in[5], MOD, 3); }
    if constexpr (PH == 7 || PH == 16) { constexpr int l = (PH == 16); ProbBf16Out<1> Pb; Pb.S.init(T, DFF, F.G, F.bid); Pb.K = D; Pb.ldb = D; Pb.lda = D; Pb.a_kstep = 128; Pb.a_hstep = (size_t)128 * D * 2; Pb.A = (const bf16_t*)(F.ws + WS_H); Pb.W = (const bf16_t*)(F.ws + WS_W1) + (size_t)l * DFF * D;
            Pb.O = (bf16_t*)(F.ws + WS_A2); Pb.ldc = DFF;
            pg8::gemm_phase<ProbBf16Out<1>, true, true>(ring, Pb); }
    if constexpr (PH == 8 || PH == 17) { constexpr int l = (PH == 17); ProbResid Pb; Pb.S.init(T, D, F.G, F.bid); Pb.K = DFF; Pb.ldb = DFF; Pb.lda = DFF; Pb.a_kstep = 128; Pb.a_hstep = (size_t)128 * DFF * 2; Pb.A = (const bf16_t*)(F.ws + WS_A2); Pb.W = (const bf16_t*)(F.ws + WS_W2) + (size_t)l * D * DFF;
            Pb.X = Xp; Pb.gt = MOD + (size_t)l * NB * 6 * D + 5 * D;
            pg8::gemm_phase<ProbResid, true, true>(ring, Pb); }
    if constexpr (PH == 9) { phase_normmod<true>(F, F.in[4] + D, MOD + (size_t)NB * 6 * D, 0); }
    if constexpr (PH == 10) { ProbBf16Out<0> Pb; Pb.S.init(T, NQKVR, F.G, F.bid); Pb.K = D; Pb.ldb = D; Pb.lda = D; Pb.a_kstep = 128; Pb.a_hstep = (size_t)128 * D * 2; Pb.A = (const bf16_t*)(F.ws + WS_H); Pb.W = (const bf16_t*)(F.ws + WS_WIN);
            Pb.O = (bf16_t*)(F.ws + WS_QKVR); Pb.ldc = NQKVR;
            pg8::gemm_phase<ProbBf16Out<0>, true, true>(ring, Pb); }
    if constexpr (PH == 11) { phase_gla_kdec(F); }
    if constexpr (PH == 12) { phase_gla_escan(F); }
    if constexpr (PH == 13) { phase_gla_out(F); }
    if constexpr (PH == 14) { ProbResid Pb; Pb.S.init(T, D, F.G, F.bid); Pb.K = D; Pb.ldb = D; Pb.lda = NQKVR; Pb.a_kstep = 128; Pb.a_hstep = (size_t)128 * NQKVR * 2; Pb.A = (const bf16_t*)(F.ws + WS_QKVR) + QKW; Pb.W = (const bf16_t*)(F.ws + WS_WOUT);
            Pb.X = Xp; Pb.gt = MOD + (size_t)NB * 6 * D + 2 * D;
            pg8::gemm_phase<ProbResid, true, true>(ring, Pb); }
    if constexpr (PH == 15) { phase_normmod<false>(F, F.in[5] + D, MOD + (size_t)NB * 6 * D, 3); }
    if constexpr (PH == 18) { phase_final(F); }
}
#ifndef PROG_LIST
#define PROG_LIST RUNB(0) RUNB(1) RUNB(2) RUNB(3) RUNB(4) RUNB(5) RUNB(6) RUNB(7) RUNB(8) RUNB(9) RUNB(10) RUNB(11) RUNB(12) RUNB(13) RUNB(14) RUNB(15) RUNB(16) RUNB(17) RUNL(18)
#endif
__global__ void __launch_bounds__(NTHR, 2) mega_fwd(Args args) {
    extern __shared__ __attribute__((aligned(16))) unsigned char lds_raw[];
    Frame F; F.lds = (LAS unsigned char*)lds_raw; F.tid = threadIdx.x; F.lane = F.tid & 63; F.wave = __builtin_amdgcn_readfirstlane(F.tid >> 6);
    F.G = gridDim.x; F.bid = blockIdx.x; F.out = args.out; F.ws = args.ws;
#pragma unroll
    for (int i = 0; i < 23; ++i) F.in[i] = args.in[i];
    volatile LAS unsigned* MISC = (volatile LAS unsigned*)(F.lds + MISC_OFF);
    for (int u = F.tid; u < (LDS_BYTES - LDSCTL_OFF) / 4; u += NTHR) ((LAS unsigned*)(F.lds + LDSCTL_OFF))[u] = 0u;
    __syncthreads();
    XcdBarrier bar = xcd_barrier_post((unsigned*)(F.ws + WS_CTL) + CW_BAR, MISC + 8);
    const unsigned long long pmask = args.pmask; constexpr int cbase = __COUNTER__ + 1;
#define RUNB(k) if ((pmask >> (__COUNTER__ - cbase)) & 1ull) { run_phase<k>(F); } xcd_barrier(bar);
#define RUNL(k) if ((pmask >> (__COUNTER__ - cbase)) & 1ull) { run_phase<k>(F); }
    PROG_LIST
#undef RUNB
#undef RUNL
}

extern "C" void kernel_launch(void* const* d_in, const int* in_sizes, int n_in, void* d_out, int out_size, void* d_ws, size_t ws_size, hipStream_t stream) {
    static int grid = 0;
    if (grid == 0) {
        int dev = 0, cus = 0;
        if (n_in != 23 || out_size != T * D || ws_size < WS_END) { fprintf(stderr, "kernel_launch: unexpected shapes (n_in %d out %d ws %zu)\n", n_in, out_size, ws_size); grid = -1; return; }
        if (hipGetDevice(&dev) != hipSuccess || hipDeviceGetAttribute(&cus, hipDeviceAttributeMultiprocessorCount, dev) != hipSuccess) { grid = -1; return; }
        if (hipFuncSetAttribute((const void*)mega_fwd, hipFuncAttributeMaxDynamicSharedMemorySize, LDS_BYTES) != hipSuccess) { fprintf(stderr, "kernel_launch: hipFuncSetAttribute failed\n"); grid = -1; return; }
        int per_cu = 0;
        if (hipOccupancyMaxActiveBlocksPerMultiprocessor(&per_cu, (const void*)mega_fwd, NTHR, LDS_BYTES) != hipSuccess || per_cu < 1) fprintf(stderr, "kernel_launch: occupancy query reports %d\n", per_cu);
        (void)hipGetLastError();
        grid = cus;
        if (grid != 256) fprintf(stderr, "kernel_launch: %d CUs (built for 256)\n", grid);
    }
    if (grid < 0) return;
    (void)hipMemsetAsync((char*)d_ws + WS_CTL, 0, CTL_ZERO_BYTES, stream);
    Args a{};
    for (int i = 0; i < 23; ++i) a.in[i] = (const float*)d_in[i];
    a.out = (float*)d_out; a.ws = (unsigned char*)d_ws; a.pmask = ~0ull;
    hipLaunchKernelGGL(mega_fwd, dim3(grid), dim3(NTHR), LDS_BYTES, stream, a);
}
```

```cpp
#include <hip/hip_runtime.h>
#include <cstdio>
#include <cstdint>
#include <math.h>

#define LAS __attribute__((address_space(3)))
#define GAS __attribute__((address_space(1)))
typedef unsigned short bf16_t;
typedef short bf16x8 __attribute__((ext_vector_type(8)));
typedef float f32x4 __attribute__((ext_vector_type(4)));
typedef float f32x2 __attribute__((ext_vector_type(2)));
typedef unsigned u32x4 __attribute__((ext_vector_type(4)));
typedef unsigned u32x2 __attribute__((ext_vector_type(2)));

constexpr int NB = 4, SEQ = 4096, D = 1024, T = NB * SEQ;
constexpr int G = 64, P = 64, HG = 16;
constexpr int QC = 16, NCH = SEQ / QC, BC = NB * NCH;
constexpr int UK = QC * HG, UA = UK + 2 * P;
constexpr int NH = 4, DK = 128, DV = 256, QKW = 512, RANK = 16, GIN = 3088, DFF = 4096, CH = 64;
constexpr int NQKVR = 3072;
constexpr float EPS = 1e-6f;

constexpr size_t MiB = 1u << 20;
constexpr size_t WS_CTL = 0, CTL_ZERO_BYTES = 1 * MiB;
constexpr size_t WS_MOD = 1 * MiB;
constexpr size_t WS_GLR = 2 * MiB;
constexpr size_t WS_WGLU = 4 * MiB;
constexpr size_t WS_WIN = 8 * MiB;
constexpr size_t WS_WOUT = 14 * MiB;
constexpr size_t WS_W1 = 16 * MiB;
constexpr size_t WS_W2 = 32 * MiB;
constexpr size_t WS_TT = 48 * MiB;
constexpr size_t WS_WST = 60 * MiB;
constexpr size_t WS_UAUG = 64 * MiB;
constexpr size_t WS_SLOC = 112 * MiB;
constexpr size_t WS_ZT = 144 * MiB;
constexpr size_t WS_A2 = 64 * MiB;
constexpr size_t WS_QKVR = 64 * MiB;
constexpr size_t WS_KVF = 160 * MiB;
constexpr size_t WS_DEC = 3 * MiB;
constexpr size_t WS_SSP = 240 * MiB;
constexpr size_t WS_H = 208 * MiB;
constexpr size_t WS_AOUT = 208 * MiB;
constexpr size_t WS_END = 248 * MiB;
constexpr size_t WS_DUMMY = 64 * MiB;
constexpr int CW_BAR = 4096;

constexpr int LDS_BYTES = 147456, LDSCTL_OFF = LDS_BYTES - 512, MISC_OFF = LDSCTL_OFF + 320, RING_BYTES = LDSCTL_OFF;
constexpr int NWAVES = 8, NTHR = NWAVES * 64;

__device__ __forceinline__ unsigned f2bf(float f) { unsigned u = __builtin_bit_cast(unsigned, f); return (u + 0x7fffu + ((u >> 16) & 1u)) >> 16; }
__device__ __forceinline__ unsigned pk2(float lo, float hi) { return f2bf(lo) | (f2bf(hi) << 16); }
__device__ __forceinline__ float bf2f(unsigned short b) { return __builtin_bit_cast(float, (unsigned)b << 16); }
typedef __bf16 bf16x2_t __attribute__((ext_vector_type(2)));
__device__ __forceinline__ unsigned cvt_pk_bf16(float lo, float hi) { const f32x2 v = {lo, hi}; const bf16x2_t b = __builtin_convertvector(v, bf16x2_t); return __builtin_bit_cast(unsigned, b); }
__device__ __forceinline__ float fast_sigmoid(float x) { return __builtin_amdgcn_rcpf(1.f + __builtin_amdgcn_exp2f(-1.4426950408889634f * x)); }
__device__ __forceinline__ float fast_gelu_tanh(float x) { const float u = 0.7978845608028654f * (x + 0.044715f * x * x * x); return x * fast_sigmoid(2.f * u); }
__device__ __forceinline__ float silu_f(float x) { return x / (1.f + expf(-x)); }
__device__ __forceinline__ float logsigmoid_f(float x) { return fminf(x, 0.f) - log1pf(expf(-fabsf(x))); }
__device__ __forceinline__ float wave_sum(float v) {
#pragma unroll
    for (int o = 1; o < 64; o <<= 1) v += __shfl_xor(v, o);
    return v;
}
#define LDS_WAIT() asm volatile("s_waitcnt lgkmcnt(0)" ::: "memory")
#define WG_BAR() do { asm volatile("s_waitcnt lgkmcnt(0)" ::: "memory"); __builtin_amdgcn_s_barrier(); asm volatile("" ::: "memory"); } while (0)
#define VM_WAIT() asm volatile("s_waitcnt vmcnt(0)" ::: "memory")

namespace pg8 {
constexpr int BM = 256, BK = 64, HALF = 128, HTB = HALF * BK * 2, STAGE_BYTES = 8 * HTB, NXCD = 8, WGM = 8;
__host__ __device__ __forceinline__ int lds_byte(int r, int c) { const int st = (r >> 4) * 2 + (c >> 5), rr = r & 15, cc = c & 31, ob = rr * 64 + cc * 2; return st * 1024 + (ob ^ (((ob >> 9) & 1) << 5)); }
__host__ __device__ __forceinline__ void stage_rc(int b, int& R, int& C) { const int st = b / 1024, sb = b % 1024, swz = sb ^ (((sb >> 9) & 1) << 5); R = (st >> 1) * 16 + swz / 64; C = (st & 1) * 32 + (swz % 64) / 2; }
__host__ __device__ __forceinline__ int perm32(int rho) { const int n = rho >> 4, i = rho & 15; return 8 * (i >> 2) + 4 * n + (i & 3); }
struct Unit { int pm, pn; };
struct StaticOrder {
    int nM, nN, nwg, G, c;
    __device__ void init(int M, int N, int G_, int c_) { nM = M / BM; nN = N / BM; nwg = nM * nN; G = G_; c = c_; }
    __device__ bool next(int i, Unit& u) const {
        const long L = (long)i * G + c; if (L >= nwg) return false;
        int wgid = (int)L; { const int q = nwg / NXCD, r = nwg % NXCD, xcd = wgid % NXCD, off = wgid / NXCD; wgid = (xcd < r ? xcd * (q + 1) : r * (q + 1) + (xcd - r) * q) + off; }
        const int nig = WGM * nN, gid = wgid / nig, fm = gid * WGM, gsz = (nM - fm) < WGM ? (nM - fm) : WGM;
        u.pm = fm + ((wgid % nig) % gsz); u.pn = (wgid % nig) / gsz; return true;
    }
};
template <class Prob, bool ALIGN_EPI, bool SP2>
__device__ __forceinline__ void gemm_phase(LAS unsigned char* lds, const Prob& Pb) {
    const int tid = threadIdx.x, wid = __builtin_amdgcn_readfirstlane(tid >> 6), lane = tid & 63, wr = wid >> 2, wc = wid & 3, fr = lane & 15, fq = lane >> 4;
    const int K = Pb.K, nt = K / BK;
    unsigned voffA[2], voffB[2];
#pragma unroll
    for (int i = 0; i < 2; ++i) { int R, C; stage_rc(tid * 16 + i * 8192, R, C); const int Rb = Prob::PERM ? ((R & ~31) + perm32(R & 31)) : R;
        voffA[i] = Pb.a_voff(R, C); voffB[i] = (unsigned)(Rb * Pb.ldb + C) * 2u; }
    const size_t kstepA = Pb.a_kstep, hstepA = Pb.a_hstep, kstepB = (size_t)(BK * 2), hstepB = (size_t)HALF * Pb.ldb * 2;
    const unsigned ldsw = (unsigned)wid * 1024u;
    const int aoff = lds_byte(wr * 64 + fr, fq * 8), boff = lds_byte(wc * 32 + fr, fq * 8);
#define PG8_SA(b, h) (((b) * 2 + (h)) * HTB)
#define PG8_SB(b, h) ((4 + (b) * 2 + (h)) * HTB)
#define PG8_STAGE(bufoff, gbase, voff) do { _Pragma("unroll") for (int _i = 0; _i < 2; ++_i) \
        __builtin_amdgcn_global_load_lds((const unsigned*)((const char*)(gbase) + (voff)[_i]), (LAS unsigned*)(lds + (bufoff) + ldsw + _i * 8192), 16, 0, 0); } while (0)
#define PG8_LDA(dst, b, h) do { _Pragma("unroll") for (int m = 0; m < 4; ++m) _Pragma("unroll") for (int k = 0; k < 2; ++k) dst[m][k] = *(const LAS bf16x8*)(lds + PG8_SA(b, h) + aoff + m * 2048 + k * 1024); } while (0)
#define PG8_LDB(dst, b, h) do { _Pragma("unroll") for (int n = 0; n < 2; ++n) _Pragma("unroll") for (int k = 0; k < 2; ++k) dst[n][k] = *(const LAS bf16x8*)(lds + PG8_SB(b, h) + boff + n * 2048 + k * 1024); } while (0)
#define PG8_MMA(ai, bj, At, Bt) do { __builtin_amdgcn_s_setprio(1); _Pragma("unroll") for (int m = 0; m < 4; ++m) _Pragma("unroll") for (int n = 0; n < 2; ++n) _Pragma("unroll") for (int k = 0; k < 2; ++k) \
        acc[ai][bj][m][n] = __builtin_amdgcn_mfma_f32_16x16x32_bf16(Bt[n][k], At[m][k], acc[ai][bj][m][n], 0, 0, 0); __builtin_amdgcn_s_setprio(0); } while (0)
#define PG8_WAIT_V(n) asm volatile("s_waitcnt vmcnt(" #n ")" ::: "memory")
#define PG8_WAIT_L(n) asm volatile("s_waitcnt lgkmcnt(" #n ")" ::: "memory")
#define PG8_BAR __builtin_amdgcn_s_barrier()
#define PG8_SCHED __builtin_amdgcn_sched_barrier(0)
    Unit cur, nxt; int ui = 0;
    if (!Pb.next(0, cur)) return;
    f32x4 acc[2][2][4][2];
#pragma unroll
    for (int a = 0; a < 2; ++a)
#pragma unroll
        for (int b = 0; b < 2; ++b)
#pragma unroll
            for (int m = 0; m < 4; ++m)
#pragma unroll
                for (int n = 0; n < 2; ++n) acc[a][b][m][n] = (f32x4){0.f, 0.f, 0.f, 0.f};
    bf16x8 At[4][2], B0[2][2], B1[2][2];
    const char* cA = Pb.a_base(cur); const char* cB = Pb.b_base(cur);
    if constexpr (SP2) {
        PG8_STAGE(PG8_SB(0, 0), cB, voffB); PG8_STAGE(PG8_SB(0, 1), cB + hstepB, voffB); PG8_STAGE(PG8_SA(0, 0), cA, voffA); PG8_STAGE(PG8_SA(0, 1), cA + hstepA, voffA);
        if (wr == 1) PG8_BAR;
        PG8_WAIT_V(2); PG8_BAR;
        PG8_STAGE(PG8_SB(1, 0), cB + kstepB, voffB); PG8_STAGE(PG8_SA(1, 0), cA + kstepA, voffA); PG8_STAGE(PG8_SB(1, 1), cB + hstepB + kstepB, voffB);
        PG8_WAIT_V(6); PG8_BAR;
    } else {
        PG8_STAGE(PG8_SB(0, 0), cB, voffB); PG8_STAGE(PG8_SA(0, 0), cA, voffA); PG8_STAGE(PG8_SB(0, 1), cB + hstepB, voffB); PG8_STAGE(PG8_SA(0, 1), cA + hstepA, voffA);
        if (wr == 1) PG8_BAR;
        PG8_WAIT_V(4); PG8_BAR;
        PG8_STAGE(PG8_SB(1, 0), cB + kstepB, voffB); PG8_STAGE(PG8_SA(1, 0), cA + kstepA, voffA); PG8_STAGE(PG8_SB(1, 1), cB + hstepB + kstepB, voffB);
        PG8_WAIT_V(6); PG8_BAR;
    }
    for (;;) {
        const bool has_next = Pb.next(ui + 1, nxt);
        const char* nA = has_next ? Pb.a_base(nxt) : cA; const char* nB = has_next ? Pb.b_base(nxt) : cB;
        for (int t = 0; t < nt; t += 2) {
            const bool last = (t == nt - 2);
            const char* a1 = cA + (size_t)(t + 1) * kstepA;
            const char* a2 = last ? nA : cA + (size_t)(t + 2) * kstepA; const char* b2 = last ? nB : cB + (size_t)(t + 2) * kstepB;
            const char* a3 = a2 + kstepA; const char* b3 = b2 + kstepB;
            if constexpr (SP2) {
            PG8_LDB(B0, 0, 0); PG8_LDB(B1, 0, 1); PG8_SCHED; PG8_LDA(At, 0, 0); PG8_STAGE(PG8_SA(1, 1), a1 + hstepA, voffA);
            PG8_WAIT_V(8); PG8_WAIT_L(0); PG8_BAR; PG8_MMA(0, 0, At, B0); PG8_MMA(0, 1, At, B1); PG8_BAR; PG8_SCHED;
            PG8_LDA(At, 0, 1); PG8_STAGE(PG8_SB(0, 0), b2, voffB); PG8_STAGE(PG8_SB(0, 1), b2 + hstepB, voffB); PG8_STAGE(PG8_SA(0, 0), a2, voffA);
            PG8_WAIT_V(8); PG8_WAIT_L(0); PG8_BAR; PG8_MMA(1, 0, At, B0); PG8_MMA(1, 1, At, B1); PG8_BAR; PG8_SCHED;
            PG8_LDB(B0, 1, 0); PG8_LDB(B1, 1, 1); PG8_SCHED; PG8_LDA(At, 1, 0); PG8_STAGE(PG8_SA(0, 1), a2 + hstepA, voffA);
            PG8_WAIT_V(8); PG8_WAIT_L(0); PG8_BAR; PG8_MMA(0, 0, At, B0); PG8_MMA(0, 1, At, B1); PG8_BAR; PG8_SCHED;
            PG8_LDA(At, 1, 1); PG8_STAGE(PG8_SB(1, 0), b3, voffB); PG8_STAGE(PG8_SB(1, 1), b3 + hstepB, voffB); PG8_STAGE(PG8_SA(1, 0), a3, voffA);
            PG8_WAIT_V(8); PG8_WAIT_L(0); PG8_BAR; PG8_MMA(1, 0, At, B0); PG8_MMA(1, 1, At, B1); PG8_BAR; PG8_SCHED;
            } else {
            PG8_LDB(B0, 0, 0); PG8_SCHED; PG8_LDA(At, 0, 0); PG8_STAGE(PG8_SA(1, 1), a1 + hstepA, voffA);
            PG8_WAIT_L(8); PG8_BAR; PG8_WAIT_L(0); PG8_MMA(0, 0, At, B0); PG8_BAR; PG8_SCHED;
            PG8_LDB(B1, 0, 1); PG8_STAGE(PG8_SB(0, 0), b2, voffB);
            PG8_BAR; PG8_WAIT_L(0); PG8_MMA(0, 1, At, B1); PG8_BAR;
            PG8_LDA(At, 0, 1); PG8_STAGE(PG8_SA(0, 0), a2, voffA);
            PG8_BAR; PG8_WAIT_L(0); PG8_MMA(1, 0, At, B0); PG8_BAR; PG8_SCHED;
            PG8_STAGE(PG8_SB(0, 1), b2 + hstepB, voffB);
            PG8_WAIT_V(6); PG8_BAR; PG8_MMA(1, 1, At, B1); PG8_BAR;
            PG8_LDB(B0, 1, 0); PG8_SCHED; PG8_LDA(At, 1, 0); PG8_STAGE(PG8_SA(0, 1), a2 + hstepA, voffA);
            PG8_WAIT_L(8); PG8_BAR; PG8_WAIT_L(0); PG8_MMA(0, 0, At, B0); PG8_BAR; PG8_SCHED;
            PG8_LDB(B1, 1, 1); PG8_STAGE(PG8_SB(1, 0), b3, voffB);
            PG8_BAR; PG8_WAIT_L(0); PG8_MMA(0, 1, At, B1); PG8_BAR;
            PG8_LDA(At, 1, 1); PG8_STAGE(PG8_SA(1, 0), a3, voffA);
            PG8_BAR; PG8_WAIT_L(0); PG8_MMA(1, 0, At, B0); PG8_BAR; PG8_SCHED;
            PG8_STAGE(PG8_SB(1, 1), b3 + hstepB, voffB);
            PG8_WAIT_V(6); PG8_BAR; PG8_MMA(1, 1, At, B1); PG8_BAR;
            }
        }
        if constexpr (ALIGN_EPI) { if (wr == 0) PG8_BAR; }
        Pb.epi(acc, cur, wr, wc, fr, fq);
        if (!has_next) break;
#pragma unroll
        for (int a = 0; a < 2; ++a)
#pragma unroll
            for (int b = 0; b < 2; ++b)
#pragma unroll
                for (int m = 0; m < 4; ++m)
#pragma unroll
                    for (int n = 0; n < 2; ++n) acc[a][b][m][n] = (f32x4){0.f, 0.f, 0.f, 0.f};
        cur = nxt; cA = nA; cB = nB; ++ui;
        if constexpr (ALIGN_EPI) { if (wr == 1) PG8_BAR; }
    }
    PG8_WAIT_V(0);
    if constexpr (!ALIGN_EPI) { if (wr == 0) PG8_BAR; }
    PG8_BAR;
#undef PG8_SA
#undef PG8_SB
#undef PG8_STAGE
#undef PG8_LDA
#undef PG8_LDB
#undef PG8_MMA
#undef PG8_WAIT_V
#undef PG8_WAIT_L
#undef PG8_BAR
#undef PG8_SCHED
}
}
using pg8::Unit;
typedef f32x4 AccT[2][2][4][2];

#define XB_TMO      128
#define XB_XCNT(j)  (256  + 64 * (j))
#define XB_XSUB(j)  (1280 + 64 * (j))
#define XB_XGEN(j)  (2304 + 64 * (j))
#define XB_TOP      3328
#define XB_TOPGEN   3392
#define XCD_BAR_WORDS 3456
#define XB_SPIN_CAP (1u << 18)
__device__ __forceinline__ unsigned xb_ld(unsigned* p)              { return __hip_atomic_load(p, __ATOMIC_RELAXED, __HIP_MEMORY_SCOPE_AGENT); }
__device__ __forceinline__ unsigned xb_add(unsigned* p, unsigned v) { return __hip_atomic_fetch_add(p, v, __ATOMIC_RELAXED, __HIP_MEMORY_SCOPE_AGENT); }
__device__ __forceinline__ unsigned xb_xcc_id() { return (unsigned)__builtin_amdgcn_s_getreg((3 << 11) | 20) & 0xFu; }
#define XB_SPIN(cond, bar) do { unsigned _sp = 0; while (cond) { __builtin_amdgcn_s_sleep(1); \
    if ((++_sp & 255u) == 0u) { if (xb_ld(&(bar)[XB_TMO])) break; if (_sp > XB_SPIN_CAP) { atomicAdd(&(bar)[XB_TMO], 1u); break; } } } } while (0)
struct XcdBarrier { unsigned* bar; unsigned x; volatile LAS unsigned* st; };
__device__ __forceinline__ XcdBarrier xcd_barrier_post(unsigned* bar, volatile LAS unsigned* st) {
    XcdBarrier b; b.bar = bar; b.x = xb_xcc_id(); b.st = st;
    if (threadIdx.x == 0) (void)xb_add(&bar[XB_XCNT(b.x)], 1u);
    return b;
}
__device__ __forceinline__ void xcd_barrier_complete(unsigned* bar, unsigned x, unsigned& nloc, unsigned& nx) {
    const unsigned Gn = gridDim.x * gridDim.y * gridDim.z;
    unsigned sum, cnt, mine, sp = 0u;
    for (;;) {
        sum = 0u; cnt = 0u; mine = 0u;
#pragma unroll
        for (unsigned j = 0; j < 16; ++j) { const unsigned c = xb_ld(&bar[XB_XCNT(j)]); sum += c; cnt += (c > 0u) ? 1u : 0u; mine = (j == x) ? c : mine; }
        if (sum == Gn) break;
        __builtin_amdgcn_s_sleep(1);
        if ((++sp & 255u) == 0u) { if (xb_ld(&bar[XB_TMO])) break; if (sp > XB_SPIN_CAP) { atomicAdd(&bar[XB_TMO], 1u); break; } }
    }
    nloc = mine > 0u ? mine : 1u; nx = cnt > 0u ? cnt : 1u;
}
__device__ __forceinline__ void xcd_barrier(const XcdBarrier& b) {
    asm volatile("s_waitcnt vmcnt(0)" ::: "memory");
    __syncthreads();
    if (threadIdx.x == 0) {
        unsigned* bar = b.bar;
        __builtin_amdgcn_s_waitcnt(0);
        unsigned nloc = b.st[0], nx = b.st[1];
        if (nloc == 0u) { xcd_barrier_complete(bar, b.x, nloc, nx); b.st[0] = nloc; b.st[1] = nx; }
        const unsigned old = xb_add(&bar[XB_XSUB(b.x)], 1u);
        const unsigned gen = old / nloc;
        if (old + 1u == (gen + 1u) * nloc) {
            __builtin_amdgcn_fence(__ATOMIC_RELEASE, "agent");
            asm volatile("s_waitcnt vmcnt(0)" ::: "memory");
            const unsigned og = xb_add(&bar[XB_TOP], 1u);
            const unsigned tg = og / nx;
            if (og + 1u == (tg + 1u) * nx) xb_add(&bar[XB_TOPGEN], 1u);
            else XB_SPIN(xb_ld(&bar[XB_TOPGEN]) == tg, bar);
            __builtin_amdgcn_fence(__ATOMIC_ACQUIRE, "agent");
            xb_add(&bar[XB_XGEN(b.x)], 1u);
            asm volatile("s_waitcnt vmcnt(0)" ::: "memory");
        } else {
            XB_SPIN(xb_ld(&bar[XB_XGEN(b.x)]) == gen, bar);
            __builtin_amdgcn_fence(__ATOMIC_ACQUIRE, "agent");
            asm volatile("s_waitcnt vmcnt(0)" ::: "memory");
        }
    }
    __syncthreads();
}

struct Args { const float* in[23]; float* out; unsigned char* ws; unsigned long long pmask; };
struct Frame {
    LAS unsigned char* lds; int tid, lane, wave, G, bid;
    const float* in[23]; float* out; unsigned char* ws;
};

__device__ __forceinline__ void phase_mod(Frame& F) {
    const float* c = F.in[1]; const float* w_ada = F.in[2]; const float* b_ada = F.in[3]; float* mod = (float*)(F.ws + WS_MOD);
    LAS float* cs = (LAS float*)F.lds;
    LAS f32x4* part = (LAS f32x4*)(F.lds + 16384);
    for (int i = F.tid; i < NB * D; i += NTHR) cs[i] = silu_f(c[i]);
    __syncthreads();
    for (int blk = F.bid; blk < 2 * 6 * D / 48; blk += F.G) {
        const int gn0 = blk * 48, li = gn0 / (6 * D), n0 = gn0 % (6 * D);
        const int kq = F.lane / 12, cq = F.lane % 12; const bool act = F.lane < 60;
        const float* w = w_ada + (size_t)li * D * 6 * D + n0 + 4 * cq;
        f32x4 a0 = (f32x4){0.f, 0.f, 0.f, 0.f}, a1 = a0, a2 = a0, a3 = a0;
        if (act) {
#pragma unroll 13
            for (int i = 0; i < 26; ++i) { const int kl = kq + 5 * i; if (kl < 128) { const int k = 128 * F.wave + kl; const f32x4 wv = *(const GAS f32x4*)(w + (size_t)k * 6 * D);
                a0 += cs[k] * wv; a1 += cs[D + k] * wv; a2 += cs[2 * D + k] * wv; a3 += cs[3 * D + k] * wv; } }
            LAS f32x4* pp = part + ((F.wave * 5 + kq) * 12 + cq) * 4; pp[0] = a0; pp[1] = a1; pp[2] = a2; pp[3] = a3;
        }
        __syncthreads();
        if (F.tid < 48 * NB) { const int bq = F.tid / 48, col = F.tid % 48, cq2 = col >> 2, e = col & 3; float sum = 0.f;
            for (int i = 0; i < 40; ++i) sum += part[(i * 12 + cq2) * 4 + bq][e];
            mod[((size_t)li * NB + bq) * 6 * D + n0 + col] = sum + b_ada[li * 6 * D + n0 + col]; }
        __syncthreads();
    }
}
__device__ __forceinline__ void transpose_item(const float* W, int ldw, int src_col0, bf16_t* WT, int Kd, int dst_row0, int k0, float scale, LAS float* scr, int lane) {
    const int kr = lane >> 4, c4 = lane & 15;
#pragma unroll 8
    for (int i = 0; i < 16; ++i) { const int kk = 4 * i + kr; const f32x4 v = *(const GAS f32x4*)(W + (size_t)(k0 + kk) * ldw + src_col0 + 4 * c4) * scale;
        LAS float* d = scr + kk * 65 + 4 * c4; d[0] = v.x; d[1] = v.y; d[2] = v.z; d[3] = v.w; }
    LDS_WAIT(); asm volatile("" ::: "memory");
    const int c = lane & 7;
#pragma unroll
    for (int j = 0; j < 8; ++j) { const int n = (lane >> 3) + 8 * j; const LAS float* sp = scr + (8 * c) * 65 + n;
        u32x4 o; o.x = pk2(sp[0 * 65], sp[1 * 65]); o.y = pk2(sp[2 * 65], sp[3 * 65]); o.z = pk2(sp[4 * 65], sp[5 * 65]); o.w = pk2(sp[6 * 65], sp[7 * 65]);
        *(GAS u32x4*)(WT + (size_t)(dst_row0 + n) * Kd + k0 + 8 * c) = o; }
    LDS_WAIT(); asm volatile("" ::: "memory");
}
__device__ __forceinline__ void phase_convert(Frame& F) {
    LAS float* scr = (LAS float*)(F.lds + F.wave * 16640);
    const int gw = F.bid * NWAVES + F.wave, NGW = F.G * NWAVES;
    constexpr int I_GLU = (D / 64) * (2 * D / 64), I_IN = (D / 64) * (NQKVR / 64), I_OUT = (D / 64) * (D / 64), I_1 = (D / 64) * (DFF / 64), I_2 = (DFF / 64) * (D / 64);
    constexpr int NITEMS = I_GLU + I_IN + I_OUT + 2 * I_1 + 2 * I_2;
    bf16_t* WGLU = (bf16_t*)(F.ws + WS_WGLU); bf16_t* WIN = (bf16_t*)(F.ws + WS_WIN); bf16_t* WOUT = (bf16_t*)(F.ws + WS_WOUT);
    bf16_t* W1 = (bf16_t*)(F.ws + WS_W1); bf16_t* W2 = (bf16_t*)(F.ws + WS_W2);
    for (int it = gw; it < NITEMS; it += NGW) {
        int r = it;
        if (r < I_GLU) { const int nblk = 2 * D / 64, kb = r / nblk, nb = r % nblk, n0 = nb * 64;
            const int isg = n0 >= D, nn = isg ? n0 - D : n0, drow = 256 * (nn / 128) + 128 * isg + (nn % 128);
            transpose_item(F.in[14], 2 * D, n0, WGLU, D, drow, kb * 64, 1.f, scr, F.lane); continue; } r -= I_GLU;
        if (r < I_IN) { const int nblk = NQKVR / 64, kb = r / nblk, nb = r % nblk, n0 = nb * 64; const int src = n0 < 2048 ? n0 : n0 + RANK;
            transpose_item(F.in[15], GIN, src, WIN, D, n0, kb * 64, n0 < QKW ? 0.08838834764831845f : 1.f, scr, F.lane); continue; } r -= I_IN;
        if (r < I_OUT) { const int nblk = D / 64, kb = r / nblk, nb = r % nblk; transpose_item(F.in[19], D, nb * 64, WOUT, D, nb * 64, kb * 64, 1.f, scr, F.lane); continue; } r -= I_OUT;
        if (r < 2 * I_1) { const int l = r / I_1; r -= l * I_1; const int nblk = DFF / 64, kb = r / nblk, nb = r % nblk;
            transpose_item(F.in[20] + (size_t)l * D * DFF, DFF, nb * 64, W1 + (size_t)l * DFF * D, D, nb * 64, kb * 64, 1.f, scr, F.lane); continue; } r -= 2 * I_1;
        { const int l = r / I_2; r -= l * I_2; const int nblk = D / 64, kb = r / nblk, nb = r % nblk;
            transpose_item(F.in[21] + (size_t)l * DFF * D, D, nb * 64, W2 + (size_t)l * D * DFF, DFF, nb * 64, kb * 64, 1.f, scr, F.lane); }
    }
    __syncthreads();
}
__device__ __forceinline__ void phase_s5tables(Frame& F) {
    LAS float* LAMP = (LAS float*)F.lds;
    LAS float* BB = LAMP + 17 * 64 * 2;
    LAS float* CC = BB + 64 * 16 * 2;
    LAS float* KK = CC + 16 * 64 * 2;
    const float* a_re = F.in[6]; const float* a_im = F.in[7]; const float* log_dt = F.in[8]; const float* b_re = F.in[9]; const float* b_im = F.in[10];
    const float* c_re = F.in[11]; const float* c_im = F.in[12]; const float* dsk = F.in[13];
    bf16_t* TT = (bf16_t*)(F.ws + WS_TT); bf16_t* WST = (bf16_t*)(F.ws + WS_WST);
    for (int job = F.bid; job < 4 * G; job += F.G) { const int g = job >> 2, qt = job & 3;
        __syncthreads();
        const double dt = exp((double)log_dt[g]);
        for (int idx = F.tid; idx < 17 * 64; idx += NTHR) { const int m = idx >> 6, p = idx & 63; const double ar = a_re[g * P + p], ai = a_im[g * P + p];
            const double mag = exp(ar * dt * m), ph = ai * dt * m; LAMP[idx * 2] = (float)(mag * cos(ph)); LAMP[idx * 2 + 1] = (float)(mag * sin(ph)); }
        for (int idx = F.tid; idx < 64 * 16; idx += NTHR) { const int p = idx >> 4, hh = idx & 15; const double ar = a_re[g * P + p], ai = a_im[g * P + p];
            const double mag = exp(ar * dt), ph = ai * dt, lr = mag * cos(ph), li = mag * sin(ph), den = ar * ar + ai * ai, nr = lr - 1.0, ni = li;
            const double fr = (nr * ar + ni * ai) / den, fi = (ni * ar - nr * ai) / den; const double br = b_re[(g * P + p) * HG + hh], bi = b_im[(g * P + p) * HG + hh];
            BB[idx * 2] = (float)(fr * br - fi * bi); BB[idx * 2 + 1] = (float)(fr * bi + fi * br); }
        for (int idx = F.tid; idx < 16 * 64; idx += NTHR) { CC[idx * 2] = c_re[g * HG * P + idx]; CC[idx * 2 + 1] = c_im[g * HG * P + idx]; }
        __syncthreads();
        for (int idx = F.tid; idx < 16 * 16 * 16; idx += NTHR) { const int m = idx >> 8, hh = (idx >> 4) & 15, h2 = idx & 15; float s = 0.f;
            for (int p = 0; p < P; ++p) { const float cr = CC[(hh * 64 + p) * 2], ci = CC[(hh * 64 + p) * 2 + 1], lr = LAMP[(m * 64 + p) * 2], li = LAMP[(m * 64 + p) * 2 + 1];
                const float clr = cr * lr - ci * li, cli = cr * li + ci * lr; s += clr * BB[(p * 16 + h2) * 2] - cli * BB[(p * 16 + h2) * 2 + 1]; }
            KK[idx] = s; }
        __syncthreads();
        for (int pc = F.tid; pc < 64 * 48; pc += NTHR) { const int row = 64 * qt + pc / 48, q = pc % 48, j = row >> 4, hh = row & 15; float v[8];
            if (q < 32) { const int s = q >> 1, h0 = (q & 1) * 8;
#pragma unroll
                for (int e = 0; e < 8; ++e) { float x = (j >= s) ? KK[((j - s) * 16 + hh) * 16 + h0 + e] : 0.f; if (s == j && hh == h0 + e) x += dsk[g * HG + hh]; v[e] = x; } }
            else {
#pragma unroll
                for (int e = 0; e < 8; ++e) { const int pcol = (q - 32) * 8 + e, p = pcol & 63; const float cr = CC[(hh * 64 + p) * 2], ci = CC[(hh * 64 + p) * 2 + 1], lr = LAMP[((j + 1) * 64 + p) * 2], li = LAMP[((j + 1) * 64 + p) * 2 + 1];
                    v[e] = pcol < 64 ? (cr * lr - ci * li) : -(cr * li + ci * lr); } }
            u32x4 o; o.x = pk2(v[0], v[1]); o.y = pk2(v[2], v[3]); o.z = pk2(v[4], v[5]); o.w = pk2(v[6], v[7]);
            *(GAS u32x4*)(TT + ((size_t)g * 256 + row) * UA + q * 8) = o; }
        for (int pc = F.tid; pc < 32 * 32; pc += NTHR) { const int row = 32 * qt + (pc >> 5), q = pc & 31, p = row & 63, s = q >> 1, h0 = (q & 1) * 8; float v[8];
            const float lr = LAMP[((15 - s) * 64 + p) * 2], li = LAMP[((15 - s) * 64 + p) * 2 + 1];
#pragma unroll
            for (int e = 0; e < 8; ++e) { const float br = BB[(p * 16 + h0 + e) * 2], bi = BB[(p * 16 + h0 + e) * 2 + 1]; v[e] = row < 64 ? (lr * br - li * bi) : (lr * bi + li * br); }
            u32x4 o; o.x = pk2(v[0], v[1]); o.y = pk2(v[2], v[3]); o.z = pk2(v[4], v[5]); o.w = pk2(v[6], v[7]);
            *(GAS u32x4*)(WST + ((size_t)g * 128 + row) * UK + q * 8) = o; }
    }
    __syncthreads();
}

__device__ __forceinline__ void normmod_row(const float* xrow, const float* nw, const float* sh, const float* sc, int lane, f32x4 (&v)[4]) {
    const GAS f32x4* xr = (const GAS f32x4*)xrow + lane; float s = 0.f;
#pragma unroll
    for (int j = 0; j < 4; ++j) { v[j] = xr[64 * j]; s += (v[j].x * v[j].x + v[j].y * v[j].y) + (v[j].z * v[j].z + v[j].w * v[j].w); }
    const float rstd = 1.0f / sqrtf(wave_sum(s) * (1.f / D) + EPS);
#pragma unroll
    for (int j = 0; j < 4; ++j) { const f32x4 w = ((const GAS f32x4*)nw)[lane + 64 * j]; v[j] = v[j] * rstd * w;
        if (sc) { const f32x4 a = ((const GAS f32x4*)sc)[lane + 64 * j], b = ((const GAS f32x4*)sh)[lane + 64 * j]; v[j] = v[j] * (1.f + a) + b; } }
}
__device__ __forceinline__ void phase_upass(Frame& F) {
    const float* x = F.in[0]; const float* nw = F.in[4]; const float* mod = (const float*)(F.ws + WS_MOD); bf16_t* UAUG = (bf16_t*)(F.ws + WS_UAUG);
    const int gw = F.bid * NWAVES + F.wave, NGW = F.G * NWAVES;
    for (int m = gw; m < T; m += NGW) {
        const int b = m / SEQ, tt = m % SEQ, c = tt / QC, s = tt % QC; const float* mb = mod + (size_t)b * 6 * D;
        f32x4 v[4]; normmod_row(x + (size_t)m * D, nw, mb, mb + D, F.lane, v);
#pragma unroll
        for (int j = 0; j < 4; ++j) { const int g = (F.lane >> 2) + 16 * j, h0 = 4 * (F.lane & 3);
            u32x2 o; o.x = pk2(v[j].x, v[j].y); o.y = pk2(v[j].z, v[j].w);
            *(GAS u32x2*)(UAUG + ((size_t)g * BC + b * NCH + c) * UA + s * 16 + h0) = o; }
    }
}
template <bool WITH_GLR>
__device__ __forceinline__ void phase_normmod(Frame& F, const float* nw, const float* mod_l  , int sh_idx) {
    const float* X = F.out; bf16_t* H = (bf16_t*)(F.ws + WS_H); float* GLR = (float*)(F.ws + WS_GLR); const float* w_in = F.in[15];
    const int gw = F.bid * NWAVES + F.wave, NGW = F.G * NWAVES;
    LAS float* wg = (LAS float*)F.lds;
    if constexpr (WITH_GLR) {
        for (int i = F.tid; i < D * RANK; i += NTHR) { const int k = i >> 4, r = i & 15; wg[r * D + k] = w_in[(size_t)k * GIN + 2048 + r]; }
        __syncthreads();
    }
    for (int m = gw; m < T; m += NGW) {
        const int b = m / SEQ; const float* mb = mod_l + (size_t)b * 6 * D + (size_t)sh_idx * D;
        f32x4 v[4]; normmod_row(X + (size_t)m * D, nw, mb, mb + D, F.lane, v);
        GAS u32x2* o8 = (GAS u32x2*)(H + (size_t)m * D) + F.lane;
#pragma unroll
        for (int j = 0; j < 4; ++j) { u32x2 o; o.x = pk2(v[j].x, v[j].y); o.y = pk2(v[j].z, v[j].w); o8[64 * j] = o; }
        if constexpr (WITH_GLR) {
            float myv = 0.f;
#pragma unroll 2
            for (int r = 0; r < RANK; ++r) { float s = 0.f;
#pragma unroll
                for (int j = 0; j < 4; ++j) { const f32x4 w = *(const LAS f32x4*)(wg + r * D + 4 * F.lane + 256 * j); s += (v[j].x * w.x + v[j].y * w.y) + (v[j].z * w.z + v[j].w * w.w); }
                s = wave_sum(s); if (F.lane == r) myv = s; }
            if (F.lane < RANK) GLR[(size_t)m * RANK + F.lane] = myv;
        }
    }
    if constexpr (WITH_GLR) __syncthreads();
}
__device__ __forceinline__ void phase_final(Frame& F) {
    float* X = F.out; const float* nw = F.in[22];
    const int gw = F.bid * NWAVES + F.wave, NGW = F.G * NWAVES;
    for (int m = gw; m < T; m += NGW) {
        f32x4 v[4]; normmod_row(X + (size_t)m * D, nw, nullptr, nullptr, F.lane, v);
        GAS f32x4* o = (GAS f32x4*)(X + (size_t)m * D) + F.lane;
#pragma unroll
        for (int j = 0; j < 4; ++j) o[64 * j] = v[j];
    }
}
__device__ __forceinline__ void phase_scan(Frame& F) {
    const float* a_re = F.in[6]; const float* a_im = F.in[7]; const float* log_dt = F.in[8];
    const float* SLOC = (const float*)(F.ws + WS_SLOC); bf16_t* UAUG = (bf16_t*)(F.ws + WS_UAUG);
    LAS float* ends = (LAS float*)F.lds;
    const int p = F.lane, w = F.wave; constexpr int SEG = NCH / NWAVES;
    for (int task = F.bid; task < G * NB; task += F.G) {
        const int g = task >> 2, b = task & 3;
        const double dt = exp((double)log_dt[g]), ar = a_re[g * P + p], ai = a_im[g * P + p];
        const double mag = exp(ar * dt * QC), ph = ai * dt * QC, magS = exp(ar * dt * QC * SEG), phS = ai * dt * QC * SEG;
        const float lr = (float)(mag * cos(ph)), li = (float)(mag * sin(ph)), sr_ = (float)(magS * cos(phS)), si_ = (float)(magS * sin(phS));
        const float* sl = SLOC + ((size_t)g * BC + b * NCH + w * SEG) * 128 + p; bf16_t* ua = UAUG + ((size_t)g * BC + b * NCH + w * SEG) * UA + UK + p;
        float lre[SEG], lim[SEG], sre[SEG], sim[SEG];
#pragma unroll
        for (int c = 0; c < SEG; ++c) { sre[c] = sl[(size_t)c * 128]; sim[c] = sl[(size_t)c * 128 + 64]; }
        float xr = 0.f, xi = 0.f;
#pragma unroll
        for (int c = 0; c < SEG; ++c) { lre[c] = xr; lim[c] = xi; const float nr = lr * xr - li * xi + sre[c], ni = lr * xi + li * xr + sim[c]; xr = nr; xi = ni; }
        __syncthreads();
        ends[(w * 64 + p) * 2] = xr; ends[(w * 64 + p) * 2 + 1] = xi;
        __syncthreads();
        float br = 0.f, bi = 0.f;
        for (int v = 0; v < w; ++v) { const float er = ends[(v * 64 + p) * 2], ei = ends[(v * 64 + p) * 2 + 1]; const float nr = sr_ * br - si_ * bi + er, ni = sr_ * bi + si_ * br + ei; br = nr; bi = ni; }
#pragma unroll
        for (int c = 0; c < SEG; ++c) { const float orr = lre[c] + br, oi = lim[c] + bi;
            ua[(size_t)c * UA] = (bf16_t)f2bf(orr); ua[(size_t)c * UA + 64] = (bf16_t)f2bf(oi);
            const float nr = lr * br - li * bi, ni = lr * bi + li * br; br = nr; bi = ni; }
    }
    __syncthreads();
}

struct ProbBase { pg8::StaticOrder S; __device__ __forceinline__ bool next(int i, Unit& u) const { return S.next(i, u); } };
struct ProbGrouped { int c; __device__ __forceinline__ bool next(int i, Unit& u) const { if (i > 0) return false; u.pm = c & 3; u.pn = c >> 2; return true; } };
struct ProbSloc : ProbGrouped {
    static constexpr bool PERM = false; int K, ldb; size_t a_kstep, a_hstep; const bf16_t* UAUG; const bf16_t* WST; float* SLOC;
    __device__ __forceinline__ unsigned a_voff(int R, int C) const { return (unsigned)(R * UA + C) * 2u; }
    __device__ __forceinline__ const char* a_base(const Unit& u) const { return (const char*)(UAUG + ((size_t)u.pn * BC + u.pm * 256) * UA); }
    __device__ __forceinline__ const char* b_base(const Unit& u) const { return (const char*)(WST + (size_t)u.pn * 128 * UK); }
    __device__ __forceinline__ void epi(const AccT& acc, const Unit& u, int wr, int wc, int fr, int fq) const {
#pragma unroll
        for (int ai = 0; ai < 2; ++ai)
#pragma unroll
            for (int m = 0; m < 4; ++m) { const int row = u.pm * 256 + ai * 128 + wr * 64 + m * 16 + fr; float* rp = SLOC + ((size_t)u.pn * BC + row) * 128 + wc * 32 + 4 * fq;
#pragma unroll
                for (int n = 0; n < 2; ++n) *(f32x4*)(rp + n * 16) = acc[ai][0][m][n]; }
    }
};
struct ProbY : ProbGrouped {
    static constexpr bool PERM = true; int K, ldb; size_t a_kstep, a_hstep; const bf16_t* UAUG; const bf16_t* TT; bf16_t* ZT;
    __device__ __forceinline__ unsigned a_voff(int R, int C) const { return (unsigned)(R * UA + C) * 2u; }
    __device__ __forceinline__ const char* a_base(const Unit& u) const { return (const char*)(UAUG + ((size_t)u.pn * BC + u.pm * 256) * UA); }
    __device__ __forceinline__ const char* b_base(const Unit& u) const { return (const char*)(TT + (size_t)u.pn * 256 * UA); }
    __device__ __forceinline__ void epi(const AccT& acc, const Unit& u, int wr, int wc, int fr, int fq) const {
#pragma unroll
        for (int ai = 0; ai < 2; ++ai)
#pragma unroll
            for (int m = 0; m < 4; ++m) { const int row = u.pm * 256 + ai * 128 + wr * 64 + m * 16 + fr; bf16_t* rp = ZT + (size_t)u.pn * T * 16 + (size_t)row * 256 + wc * 32 + 8 * fq;
#pragma unroll
                for (int bj = 0; bj < 2; ++bj) { const f32x4 v0 = acc[ai][bj][m][0], v1 = acc[ai][bj][m][1]; u32x4 w;
                    w.x = cvt_pk_bf16(fast_gelu_tanh(v0[0]), fast_gelu_tanh(v0[1])); w.y = cvt_pk_bf16(fast_gelu_tanh(v0[2]), fast_gelu_tanh(v0[3]));
                    w.z = cvt_pk_bf16(fast_gelu_tanh(v1[0]), fast_gelu_tanh(v1[1])); w.w = cvt_pk_bf16(fast_gelu_tanh(v1[2]), fast_gelu_tanh(v1[3]));
                    *(u32x4*)(rp + bj * 128) = w; } }
    }
};
struct ProbGLU : ProbBase {
    static constexpr bool PERM = false; int K, ldb; size_t a_kstep, a_hstep; const bf16_t* ZT; const bf16_t* W; const float* xin; float* X; const float* gt  ;
    __device__ __forceinline__ unsigned a_voff(int R, int C) const { return (unsigned)((C >> 4) * T * 32 + R * 32 + (C & 15) * 2); }
    __device__ __forceinline__ const char* a_base(const Unit& u) const { return (const char*)ZT + (size_t)u.pm * 256 * 32; }
    __device__ __forceinline__ const char* b_base(const Unit& u) const { return (const char*)(W + (size_t)u.pn * 256 * D); }
    __device__ __forceinline__ void epi(const AccT& acc, const Unit& u, int wr, int wc, int fr, int fq) const {
        const int b = u.pm >> 4, col0 = u.pn * 128 + wc * 32 + 4 * fq; f32x4 gv[2];
#pragma unroll
        for (int n = 0; n < 2; ++n) gv[n] = *(const f32x4*)(gt + (size_t)b * 6 * D + col0 + n * 16);
#pragma unroll
        for (int ai = 0; ai < 2; ++ai) {
            f32x4 xv[4][2];
#pragma unroll
            for (int m = 0; m < 4; ++m)
#pragma unroll
                for (int n = 0; n < 2; ++n) xv[m][n] = *(const f32x4*)(xin + (size_t)(u.pm * 256 + ai * 128 + wr * 64 + m * 16 + fr) * D + col0 + n * 16);
#pragma unroll
            for (int m = 0; m < 4; ++m) { const size_t off = (size_t)(u.pm * 256 + ai * 128 + wr * 64 + m * 16 + fr) * D + col0;
#pragma unroll
                for (int n = 0; n < 2; ++n) { const f32x4 val = acc[ai][0][m][n], gate = acc[ai][1][m][n]; f32x4 o;
                    o[0] = xv[m][n][0] + gv[n][0] * val[0] * fast_sigmoid(gate[0]); o[1] = xv[m][n][1] + gv[n][1] * val[1] * fast_sigmoid(gate[1]);
                    o[2] = xv[m][n][2] + gv[n][2] * val[2] * fast_sigmoid(gate[2]); o[3] = xv[m][n][3] + gv[n][3] * val[3] * fast_sigmoid(gate[3]);
                    *(f32x4*)(X + off + n * 16) = o; } }
            asm volatile("" ::: "memory"); }
    }
};
struct ProbPlain : ProbBase {
    int K, ldb, lda; size_t a_kstep, a_hstep; const bf16_t* A; const bf16_t* W;
    __device__ __forceinline__ unsigned a_voff(int R, int C) const { return (unsigned)(R * lda + C) * 2u; }
    __device__ __forceinline__ const char* a_base(const Unit& u) const { return (const char*)(A + (size_t)u.pm * 256 * lda); }
    __device__ __forceinline__ const char* b_base(const Unit& u) const { return (const char*)(W + (size_t)u.pn * 256 * ldb); }
};
template <int ACT  > struct ProbBf16Out : ProbPlain {
    static constexpr bool PERM = true; bf16_t* O; int ldc;
    __device__ __forceinline__ void epi(const AccT& acc, const Unit& u, int wr, int wc, int fr, int fq) const {
#pragma unroll
        for (int ai = 0; ai < 2; ++ai)
#pragma unroll
            for (int m = 0; m < 4; ++m) { bf16_t* rp = O + (size_t)(u.pm * 256 + ai * 128 + wr * 64 + m * 16 + fr) * ldc + u.pn * 256 + wc * 32 + 8 * fq;
#pragma unroll
                for (int bj = 0; bj < 2; ++bj) { f32x4 v0 = acc[ai][bj][m][0], v1 = acc[ai][bj][m][1];
                    if (ACT == 1) { v0 = __builtin_elementwise_max(v0, (f32x4){0.f, 0.f, 0.f, 0.f}); v1 = __builtin_elementwise_max(v1, (f32x4){0.f, 0.f, 0.f, 0.f}); v0 = v0 * v0; v1 = v1 * v1; }
                    u32x4 w; w.x = cvt_pk_bf16(v0[0], v0[1]); w.y = cvt_pk_bf16(v0[2], v0[3]); w.z = cvt_pk_bf16(v1[0], v1[1]); w.w = cvt_pk_bf16(v1[2], v1[3]);
                    *(u32x4*)(rp + bj * 128) = w; } }
    }
};
struct ProbResid : ProbPlain {
    static constexpr bool PERM = false; float* X; const float* gt;
    __device__ __forceinline__ void epi(const AccT& acc, const Unit& u, int wr, int wc, int fr, int fq) const {
        const int b = u.pm >> 4, col0 = u.pn * 256 + wc * 32 + 4 * fq; f32x4 gv[2][2];
#pragma unroll
        for (int bj = 0; bj < 2; ++bj)
#pragma unroll
            for (int n = 0; n < 2; ++n) gv[bj][n] = *(const f32x4*)(gt + (size_t)b * 6 * D + col0 + bj * 128 + n * 16);
#pragma unroll
        for (int ai = 0; ai < 2; ++ai)
#pragma unroll
            for (int mp = 0; mp < 2; ++mp) {
                f32x4 xv[2][2][2];
#pragma unroll
                for (int mm = 0; mm < 2; ++mm)
#pragma unroll
                    for (int bj = 0; bj < 2; ++bj)
#pragma unroll
                        for (int n = 0; n < 2; ++n) xv[mm][bj][n] = *(const f32x4*)(X + (size_t)(u.pm * 256 + ai * 128 + wr * 64 + (2 * mp + mm) * 16 + fr) * D + col0 + bj * 128 + n * 16);
#pragma unroll
                for (int mm = 0; mm < 2; ++mm) { const int m = 2 * mp + mm; const size_t off = (size_t)(u.pm * 256 + ai * 128 + wr * 64 + m * 16 + fr) * D + col0;
#pragma unroll
                    for (int bj = 0; bj < 2; ++bj)
#pragma unroll
                        for (int n = 0; n < 2; ++n) *(f32x4*)(X + off + bj * 128 + n * 16) = xv[mm][bj][n] + gv[bj][n] * acc[ai][bj][m][n]; }
                asm volatile("" ::: "memory"); }
    }
};

__device__ __forceinline__ float fast_logsigmoid(float a) {
    const float e = __builtin_amdgcn_exp2f(-1.4426950408889634f * __builtin_fabsf(a));
    return fminf(a, 0.f) - 0.6931471805599453f * __builtin_amdgcn_logf(1.f + e);
}
__device__ __forceinline__ int img_off(int row, int ch) { return 256 * row + 16 * (ch ^ (((row & 3) << 2) | ((row >> 2) & 3))); }
typedef short v4i16_t __attribute__((ext_vector_type(4)));
__device__ __forceinline__ v4i16_t lds_tr16(const LAS unsigned char* p) { return __builtin_amdgcn_ds_read_tr16_b64_v4i16((LAS v4i16_t*)p); }
__device__ __forceinline__ float sum_groups16(float x) {
    const unsigned u = __builtin_bit_cast(unsigned, x);
    auto r = __builtin_amdgcn_permlane16_swap(u, u, false, false);
    const float y = __builtin_bit_cast(float, (unsigned)r[0]) + __builtin_bit_cast(float, (unsigned)r[1]);
    const unsigned v = __builtin_bit_cast(unsigned, y);
    auto q = __builtin_amdgcn_permlane32_swap(v, v, false, false);
    return __builtin_bit_cast(float, (unsigned)q[0]) + __builtin_bit_cast(float, (unsigned)q[1]);
}
__device__ __forceinline__ void phase_gla_kdec(Frame& F) {
    const bf16_t* QKVR = (const bf16_t*)(F.ws + WS_QKVR); const float* GLR = (const float*)(F.ws + WS_GLR); const float* w2 = F.in[16]; const float* bg = F.in[17];
    bf16_t* KVF = (bf16_t*)(F.ws + WS_KVF); float* DEC = (float*)(F.ws + WS_DEC);
    LAS float* glr = (LAS float*)F.lds;
    constexpr int KP = QKW + 8, VP = DV + 8;
    LAS bf16_t* kt = (LAS bf16_t*)(F.lds + 4096);
    LAS bf16_t* vt = kt + 64 * KP;
    const int j = F.tid, lane = F.lane, w = F.wave, g = lane >> 4, li = lane & 15, q4 = li >> 2, p4 = li & 3;
    float w2c[RANK];
#pragma unroll
    for (int r = 0; r < RANK; ++r) w2c[r] = w2[r * QKW + j];
    const float bgc = bg[j];
    for (int unit = F.bid; unit < NB * (SEQ / CH); unit += F.G) {
        const size_t m0 = (size_t)unit * CH;
        __syncthreads();
        for (int i = F.tid; i < CH * RANK; i += NTHR) glr[i] = GLR[m0 * RANK + i];
#pragma unroll
        for (int i = 0; i < 8; ++i) { const int idx = F.tid + NTHR * i, row = idx >> 6, ch = idx & 63;
            *(LAS u32x4*)(kt + row * KP + ch * 8) = *(const GAS u32x4*)(QKVR + (m0 + row) * NQKVR + QKW + ch * 8); }
        u32x4 rv[4];
#pragma unroll
        for (int i = 0; i < 4; ++i) { const int idx = F.tid + NTHR * i, row = idx >> 5, ch = idx & 31; rv[i] = *(const GAS u32x4*)(QKVR + (m0 + row) * NQKVR + 2 * QKW + ch * 8); }
        __syncthreads();
        { float gc[CH]; float run = 0.f;
#pragma unroll
            for (int s = 0; s < CH; ++s) { float a = bgc;
#pragma unroll
                for (int r4 = 0; r4 < 4; ++r4) { const f32x4 gv = *(const LAS f32x4*)(glr + s * 16 + r4 * 4); a += (gv.x * w2c[4 * r4] + gv.y * w2c[4 * r4 + 1]) + (gv.z * w2c[4 * r4 + 2] + gv.w * w2c[4 * r4 + 3]); }
                run += fast_logsigmoid(a) * (1.f / 16.f); gc[s] = run; }
#pragma unroll
            for (int s = 0; s < CH; ++s) { const float kv = bf2f(kt[s * KP + j]);
                kt[s * KP + j] = (bf16_t)f2bf(kv * __builtin_amdgcn_exp2f(1.4426950408889634f * (run - gc[s]))); }
            DEC[(size_t)unit * QKW + j] = __builtin_amdgcn_exp2f(1.4426950408889634f * run); }
#pragma unroll 1
        for (int hh = 0; hh < NH; ++hh) {
            __syncthreads();
#pragma unroll
            for (int i = 0; i < 4; ++i) { const int idx = F.tid + NTHR * i, row = idx >> 5, ch = idx & 31; *(LAS u32x4*)(vt + row * VP + ch * 8) = rv[i]; }
            if (hh + 1 < NH) {
#pragma unroll
                for (int i = 0; i < 4; ++i) { const int idx = F.tid + NTHR * i, row = idx >> 5, ch = idx & 31; rv[i] = *(const GAS u32x4*)(QKVR + (m0 + row) * NQKVR + 2 * QKW + (hh + 1) * DV + ch * 8); } }
            __syncthreads();
            f32x4 acc[2][8];
#pragma unroll
            for (int e = 0; e < 2; ++e)
#pragma unroll
                for (int dt = 0; dt < 8; ++dt) acc[e][dt] = (f32x4){0.f, 0.f, 0.f, 0.f};
#pragma unroll
            for (int ks = 0; ks < 2; ++ks) { const int r0 = 32 * ks + 8 * g + q4; bf16x8 vf[2];
#pragma unroll
                for (int e = 0; e < 2; ++e) { const v4i16_t lo = lds_tr16((const LAS unsigned char*)(vt + r0 * VP + 16 * (2 * w + e) + 4 * p4)), hi = lds_tr16((const LAS unsigned char*)(vt + (r0 + 4) * VP + 16 * (2 * w + e) + 4 * p4));
                    vf[e] = (bf16x8){lo[0], lo[1], lo[2], lo[3], hi[0], hi[1], hi[2], hi[3]}; }
#pragma unroll
                for (int dt = 0; dt < 8; ++dt) { const v4i16_t lo = lds_tr16((const LAS unsigned char*)(kt + r0 * KP + hh * DK + 16 * dt + 4 * p4)), hi = lds_tr16((const LAS unsigned char*)(kt + (r0 + 4) * KP + hh * DK + 16 * dt + 4 * p4));
                    const bf16x8 kf = (bf16x8){lo[0], lo[1], lo[2], lo[3], hi[0], hi[1], hi[2], hi[3]};
#pragma unroll
                    for (int e = 0; e < 2; ++e) acc[e][dt] = __builtin_amdgcn_mfma_f32_16x16x32_bf16(kf, vf[e], acc[e][dt], 0, 0, 0); } }
            bf16_t* kvo = KVF + ((size_t)(unit * NH + hh) * 16 + 2 * w) * 8 * 256 + lane * 4;
#pragma unroll
            for (int e = 0; e < 2; ++e)
#pragma unroll
                for (int dt = 0; dt < 8; ++dt) { u32x2 o; o.x = cvt_pk_bf16(acc[e][dt][0], acc[e][dt][1]); o.y = cvt_pk_bf16(acc[e][dt][2], acc[e][dt][3]); *(GAS u32x2*)(kvo + (e * 8 + dt) * 256) = o; }
        }
    }
    __syncthreads();
}
__device__ __forceinline__ void phase_gla_escan(Frame& F) {
    bf16_t* KVF = (bf16_t*)(F.ws + WS_KVF); const float* DEC = (const float*)(F.ws + WS_DEC);
    constexpr int NCK = SEQ / CH, SLAB = NH * 16 * 8;
    for (int fid = F.bid * NTHR + F.tid; fid < NB * SLAB * 64; fid += F.G * NTHR) {
        const int lane = fid & 63, tile = fid >> 6, ts = tile & (SLAB - 1), b = tile / SLAB, dt = ts & 7, hh = ts >> 7, g = lane >> 4;
        bf16_t* kp = KVF + ((size_t)(b * NCK) * SLAB + ts) * 256 + lane * 4; const float* dp = DEC + (size_t)(b * NCK) * QKW + hh * DK + 16 * dt + 4 * g;
        f32x4 S = (f32x4){0.f, 0.f, 0.f, 0.f};
#pragma unroll 8
        for (int n = 0; n < NCK; ++n) {
            const u32x2 kv = *(const GAS u32x2*)(kp + (size_t)n * SLAB * 256); const f32x4 dc = *(const GAS f32x4*)(dp + (size_t)n * QKW);
            const f32x4 kvv = (f32x4){__builtin_bit_cast(float, kv.x << 16), __builtin_bit_cast(float, kv.x & 0xffff0000u), __builtin_bit_cast(float, kv.y << 16), __builtin_bit_cast(float, kv.y & 0xffff0000u)};
            S = S * dc + kvv;
            u32x2 o; o.x = cvt_pk_bf16(S[0], S[1]); o.y = cvt_pk_bf16(S[2], S[3]); *(GAS u32x2*)(kp + (size_t)n * SLAB * 256) = o;
        }
    }
}
__device__ __forceinline__ void phase_gla_out(Frame& F) {
    bf16_t* QKVR = (bf16_t*)(F.ws + WS_QKVR); const bf16_t* KVF = (const bf16_t*)(F.ws + WS_KVF); const float* gn = F.in[18];
    const int tid = F.tid, lane = F.lane, w = F.wave, g = lane >> 4, li = lane & 15;
    LAS float* red = (LAS float*)(F.lds + 32768);
    constexpr int SLAB = NH * 16 * 8, NU = NB * (SEQ / CH) * NH;
    int poff[2]; size_t gq[2];
#pragma unroll
    for (int i = 0; i < 2; ++i) { const int idx = tid + NTHR * i, row = idx >> 4, ch = idx & 15; poff[i] = img_off(row, ch); gq[i] = (size_t)row * NQKVR + ch * 8; }
#define GO_LOAD(un, sfr, rr, rq) do { const int hh_ = (un) & 3, bn_ = (un) >> 2; const size_t m0_ = (size_t)bn_ * CH; \
        _Pragma("unroll") for (int e = 0; e < 2; ++e) _Pragma("unroll") for (int dt = 0; dt < 8; ++dt) sfr[e][dt] = *(const GAS u32x2*)(KVF + ((size_t)bn_ * SLAB + (hh_ * 16 + 2 * w + e) * 8 + dt) * 256 + lane * 4); \
        _Pragma("unroll") for (int e = 0; e < 2; ++e) _Pragma("unroll") for (int cb = 0; cb < 4; ++cb) rr[e][cb] = *(const GAS u32x2*)(QKVR + (m0_ + 16 * cb + li) * NQKVR + 2048 + hh_ * DV + 16 * (2 * w + e) + 4 * g); \
        _Pragma("unroll") for (int i = 0; i < 2; ++i) rq[i] = *(const GAS u32x4*)(QKVR + m0_ * NQKVR + hh_ * DK + gq[i]); } while (0)
#define GO_COMPUTE(un, par, sfr, rr, rq) do { const int hh = (un) & 3, bn = (un) >> 2; const size_t m0 = (size_t)bn * CH; \
        LAS unsigned char* Bq = F.lds + (par) * 16384; LAS float* rd = red + (par) * 512; \
        _Pragma("unroll") for (int i = 0; i < 2; ++i) *(LAS u32x4*)(Bq + poff[i]) = rq[i]; \
        f32x4 gv[2]; _Pragma("unroll") for (int e = 0; e < 2; ++e) gv[e] = *(const GAS f32x4*)(gn + hh * DV + 16 * (2 * w + e) + 4 * g); \
        WG_BAR(); \
        f32x4 acc[2][4]; float ssl[4]; \
        _Pragma("unroll") for (int cb = 0; cb < 4; ++cb) { const int c = 16 * cb + li; bf16x8 qf[4]; \
            _Pragma("unroll") for (int kk = 0; kk < 4; ++kk) { const u32x2 qlo = *(const LAS u32x2*)(Bq + img_off(c, 4 * kk + (g >> 1)) + 8 * (g & 1)), qhi = *(const LAS u32x2*)(Bq + img_off(c, 4 * kk + 2 + (g >> 1)) + 8 * (g & 1)); \
                u32x4 t; t.x = qlo.x; t.y = qlo.y; t.z = qhi.x; t.w = qhi.y; qf[kk] = __builtin_bit_cast(bf16x8, t); } \
            float ss = 0.f; \
            _Pragma("unroll") for (int e = 0; e < 2; ++e) { f32x4 a = (f32x4){0.f, 0.f, 0.f, 0.f}; \
                _Pragma("unroll") for (int kk = 0; kk < 4; ++kk) { u32x4 t; t.x = sfr[e][2 * kk].x; t.y = sfr[e][2 * kk].y; t.z = sfr[e][2 * kk + 1].x; t.w = sfr[e][2 * kk + 1].y; \
                    a = __builtin_amdgcn_mfma_f32_16x16x32_bf16(__builtin_bit_cast(bf16x8, t), qf[kk], a, 0, 0, 0); } \
                acc[e][cb] = a; ss += (a[0] * a[0] + a[1] * a[1]) + (a[2] * a[2] + a[3] * a[3]); } \
            ssl[cb] = sum_groups16(ss); } \
        if (g == 0) { _Pragma("unroll") for (int cb = 0; cb < 4; ++cb) rd[w * 64 + 16 * cb + li] = ssl[cb]; } \
        WG_BAR(); \
        _Pragma("unroll") for (int cb = 0; cb < 4; ++cb) { const int c = 16 * cb + li; float tot = 0.f; \
            _Pragma("unroll") for (int v = 0; v < 8; ++v) tot += rd[v * 64 + c]; \
            const float rstd = 1.0f / sqrtf(tot * (1.f / DV) + EPS); \
            _Pragma("unroll") for (int e = 0; e < 2; ++e) { const u32x2 rv = rr[e][cb]; const float r0 = bf2f(rv.x & 0xffff), r1 = bf2f(rv.x >> 16), r2 = bf2f(rv.y & 0xffff), r3 = bf2f(rv.y >> 16); const f32x4 a = acc[e][cb]; \
                u32x2 o; o.x = cvt_pk_bf16(a[0] * rstd * gv[e][0] * r0 * fast_sigmoid(r0), a[1] * rstd * gv[e][1] * r1 * fast_sigmoid(r1)); \
                o.y = cvt_pk_bf16(a[2] * rstd * gv[e][2] * r2 * fast_sigmoid(r2), a[3] * rstd * gv[e][3] * r3 * fast_sigmoid(r3)); \
                *(GAS u32x2*)(QKVR + (m0 + c) * NQKVR + QKW + hh * DV + 16 * (2 * w + e) + 4 * g) = o; } } } while (0)
    u32x2 sA[2][8], rA[2][4], sB[2][8], rB[2][4]; u32x4 qA[2], qB[2];
    int un = F.bid;
    if (un < NU) GO_LOAD(un, sA, rA, qA);
    for (; un < NU; un += 2 * F.G) {
        const int u1 = un + F.G, u2 = un + 2 * F.G;
        GO_LOAD(u1 < NU ? u1 : un, sB, rB, qB);
        GO_COMPUTE(un, 0, sA, rA, qA);
        if (u1 < NU) { GO_LOAD(u2 < NU ? u2 : u1, sA, rA, qA); GO_COMPUTE(u1, 1, sB, rB, qB); }
    }
#undef GO_LOAD
#undef GO_COMPUTE
    __syncthreads();
}

template <int PHX> __device__ __forceinline__ void run_phase(Frame& F) {
    constexpr int PH = PHX & 63;
    const float* MOD = (const float*)(F.ws + WS_MOD);
    const bf16_t* UAUG = (const bf16_t*)(F.ws + WS_UAUG);
    LAS unsigned char* ring = F.lds;
    float* Xp = (PHX & 64) ? (float*)(F.ws + (PH == 14 ? 64 * MiB : 192 * MiB)) : F.out;

    if constexpr (PH == 0) { phase_s5tables(F); phase_mod(F); }
    if constexpr (PH == 1) { phase_upass(F); phase_convert(F); }
    if constexpr (PH == 2) { ProbSloc Pb; Pb.c = F.bid; Pb.K = UK; Pb.ldb = UK; Pb.a_kstep = 128; Pb.a_hstep = (size_t)128 * UA * 2; Pb.UAUG = UAUG; Pb.WST = (const bf16_t*)(F.ws + WS_WST); Pb.SLOC = (float*)(F.ws + WS_SLOC);
            pg8::gemm_phase<ProbSloc, true, true>(ring, Pb); }
    if constexpr (PH == 3) { phase_scan(F); }
    if constexpr (PH == 4) { ProbY Pb; Pb.c = F.bid; Pb.K = UA; Pb.ldb = UA; Pb.a_kstep = 128; Pb.a_hstep = (size_t)128 * UA * 2; Pb.UAUG = UAUG; Pb.TT = (const bf16_t*)(F.ws + WS_TT); Pb.ZT = (bf16_t*)(F.ws + WS_ZT);
            pg8::gemm_phase<ProbY, true, true>(ring, Pb); }
    if constexpr (PH == 5) { ProbGLU Pb; Pb.S.init(T, 2 * D, F.G, F.bid); Pb.K = D; Pb.ldb = D; Pb.a_kstep = (size_t)4 * T * 32; Pb.a_hstep = 128 * 32; Pb.ZT = (const bf16_t*)(F.ws + WS_ZT); Pb.W = (const bf16_t*)(F.ws + WS_WGLU);
            Pb.xin = F.in[0]; Pb.X = Xp; Pb.gt = MOD + 2 * D;
            pg8::gemm_phase<ProbGLU, true, true>(ring, Pb); }
    if constexpr (PH == 6) { phase_normmod<false>(F, F.in[5], MOD, 3); }
    if constexpr (PH == 7 || PH == 16) { constexpr int l = (PH == 16); ProbBf16Out<1> Pb; Pb.S.init(T, DFF, F.G, F.bid); Pb.K = D; Pb.ldb = D; Pb.lda = D; Pb.a_kstep = 128; Pb.a_hstep = (size_t)128 * D * 2; Pb.A = (const bf16_t*)(F.ws + WS_H); Pb.W = (const bf16_t*)(F.ws + WS_W1) + (size_t)l * DFF * D;
            Pb.O = (bf16_t*)(F.ws + WS_A2); Pb.ldc = DFF;
            pg8::gemm_phase<ProbBf16Out<1>, true, true>(ring, Pb); }
    if constexpr (PH == 8 || PH == 17) { constexpr int l = (PH == 17); ProbResid Pb; Pb.S.init(T, D, F.G, F.bid); Pb.K = DFF; Pb.ldb = DFF; Pb.lda = DFF; Pb.a_kstep = 128; Pb.a_hstep = (size_t)128 * DFF * 2; Pb.A = (const bf16_t*)(F.ws + WS_A2); Pb.W = (const bf16_t*)(F.ws + WS_W2) + (size_t)l * D * DFF;
            Pb.X = Xp; Pb.gt = MOD + (size_t)l * NB * 6 * D + 5 * D;
            pg8::gemm_phase<ProbResid, true, true>(ring, Pb); }
    if constexpr (PH == 9) { phase_normmod<true>(F, F.in[4] + D, MOD + (size_t)NB * 6 * D, 0); }
    if constexpr (PH == 10) { ProbBf16Out<0> Pb; Pb.S.init(T, NQKVR, F.G, F.bid); Pb.K = D; Pb.ldb = D; Pb.lda = D; Pb.a_kstep = 128; Pb.a_hstep = (size_t)128 * D * 2; Pb.A = (const bf16_t*)(F.ws + WS_H); Pb.W = (const bf16_t*)(F.ws + WS_WIN);
            Pb.O = (bf16_t*)(F.ws + WS_QKVR); Pb.ldc = NQKVR;
            pg8::gemm_phase<ProbBf16Out<0>, true, true>(ring, Pb); }
    if constexpr (PH == 11) { phase_gla_kdec(F); }
    if constexpr (PH == 12) { phase_gla_escan(F); }
    if constexpr (PH == 13) { phase_gla_out(F); }
    if constexpr (PH == 14) { ProbResid Pb; Pb.S.init(T, D, F.G, F.bid); Pb.K = D; Pb.ldb = D; Pb.lda = NQKVR; Pb.a_kstep = 128; Pb.a_hstep = (size_t)128 * NQKVR * 2; Pb.A = (const bf16_t*)(F.ws + WS_QKVR) + QKW; Pb.W = (const bf16_t*)(F.ws + WS_WOUT);
            Pb.X = Xp; Pb.gt = MOD + (size_t)NB * 6 * D + 2 * D;
            pg8::gemm_phase<ProbResid, true, true>(ring, Pb); }
    if constexpr (PH == 15) { phase_normmod<false>(F, F.in[5] + D, MOD + (size_t)NB * 6 * D, 3); }
    if constexpr (PH == 18) { phase_final(F); }
}
#ifndef PROG_LIST
#define PROG_LIST RUNB(0) RUNB(1) RUNS(2) RUNS(3) RUNB(4) RUNB(5) RUNB(6) RUNB(7) RUNB(8) RUNB(9) RUNB(10) RUNB(11) RUNB(12) RUNB(13) RUNB(14) RUNB(15) RUNB(16) RUNB(17) RUNL(18)
#endif
__global__ void __launch_bounds__(NTHR, 2) mega_fwd(Args args) {
    extern __shared__ __attribute__((aligned(16))) unsigned char lds_raw[];
    Frame F; F.lds = (LAS unsigned char*)lds_raw; F.tid = threadIdx.x; F.lane = F.tid & 63; F.wave = __builtin_amdgcn_readfirstlane(F.tid >> 6);
    F.G = gridDim.x; F.bid = blockIdx.x; F.out = args.out; F.ws = args.ws;
#pragma unroll
    for (int i = 0; i < 23; ++i) F.in[i] = args.in[i];
    volatile LAS unsigned* MISC = (volatile LAS unsigned*)(F.lds + MISC_OFF);
    for (int u = F.tid; u < (LDS_BYTES - LDSCTL_OFF) / 4; u += NTHR) ((LAS unsigned*)(F.lds + LDSCTL_OFF))[u] = 0u;
    __syncthreads();
    XcdBarrier bar = xcd_barrier_post((unsigned*)(F.ws + WS_CTL) + CW_BAR, MISC + 8);
    const unsigned long long pmask = args.pmask; constexpr int cbase = __COUNTER__ + 1;
#define RUNB(k) if ((pmask >> (__COUNTER__ - cbase)) & 1ull) { run_phase<k>(F); } xcd_barrier(bar);
#define RUNL(k) if ((pmask >> (__COUNTER__ - cbase)) & 1ull) { run_phase<k>(F); }
#define RUNS(k) if ((pmask >> (__COUNTER__ - cbase)) & 1ull) { run_phase<k>(F); } VM_WAIT(); __syncthreads();
    PROG_LIST
#undef RUNB
#undef RUNL
#undef RUNS
}

extern "C" void kernel_launch(void* const* d_in, const int* in_sizes, int n_in, void* d_out, int out_size, void* d_ws, size_t ws_size, hipStream_t stream) {
    static int grid = 0;
    if (grid == 0) {
        int dev = 0, cus = 0;
        if (n_in != 23 || out_size != T * D || ws_size < WS_END) { fprintf(stderr, "kernel_launch: unexpected shapes (n_in %d out %d ws %zu)\n", n_in, out_size, ws_size); grid = -1; return; }
        if (hipGetDevice(&dev) != hipSuccess || hipDeviceGetAttribute(&cus, hipDeviceAttributeMultiprocessorCount, dev) != hipSuccess) { grid = -1; return; }
        if (hipFuncSetAttribute((const void*)mega_fwd, hipFuncAttributeMaxDynamicSharedMemorySize, LDS_BYTES) != hipSuccess) { fprintf(stderr, "kernel_launch: hipFuncSetAttribute failed\n"); grid = -1; return; }
        int per_cu = 0;
        if (hipOccupancyMaxActiveBlocksPerMultiprocessor(&per_cu, (const void*)mega_fwd, NTHR, LDS_BYTES) != hipSuccess || per_cu < 1) fprintf(stderr, "kernel_launch: occupancy query reports %d\n", per_cu);
        (void)hipGetLastError();
        grid = cus;
        if (grid != 256) fprintf(stderr, "kernel_launch: %d CUs (built for 256)\n", grid);
    }
    if (grid < 0) return;
    (void)hipMemsetAsync((char*)d_ws + WS_CTL, 0, CTL_ZERO_BYTES, stream);
    Args a{};
    for (int i = 0; i < 23; ++i) a.in[i] = (const float*)d_in[i];
    a.out = (float*)d_out; a.ws = (unsigned char*)d_ws; a.pmask = ~0ull;
    hipLaunchKernelGGL(mega_fwd, dim3(grid), dim3(NTHR), LDS_BYTES, stream, a);
}
```
